# Optimizing an MI355X kernel written in HIP

```python
import jax, jax.numpy as jnp
from jax import lax
import numpy as np

D_MODEL = 2048
BATCH = 2
SEQ = 4096
DEPTH = 1

CHUNK = 64
QBLOCK = 128
D_PLE = 256
HEAD_DIM = 128
N_HEADS_FOX = 8
N_HEADS_SB = 8
W_FOX = N_HEADS_FOX * HEAD_DIM
W_SB = N_HEADS_SB * HEAD_DIM
N_GROUPS = 4
EXPERTS_PER_GROUP = 8
N_EXPERTS = N_GROUPS * EXPERTS_PER_GROUP
TOP_K_IN_GROUP = 2
D_EXPERT = 512
MOE_BLOCK = 128
EPS = 1e-6
D_IN = 3 * W_FOX + N_HEADS_FOX + 3 * W_SB + 2 * D_MODEL

kernel_name = 'hybrid_fox_stickbreaking_hiermoe_block'


def rmsnorm(x, g):
    xf = x.astype(jnp.float32)
    y = xf * lax.rsqrt(jnp.mean(xf * xf, axis=-1, keepdims=True) + EPS)
    return (y * g.astype(jnp.float32)).astype(x.dtype)


def to_blocks(t):
    b, s, h, d = t.shape
    return t.reshape(b, s // QBLOCK, QBLOCK, h, d).transpose(1, 0, 3, 2, 4)


def from_blocks(o):
    nb, b, h, qb, d = o.shape
    return o.transpose(1, 0, 3, 2, 4).reshape(b, nb * qb, h * d)


def forgetting_attention(q, k, v, log_f):
    b, s, h, d = q.shape
    nb = s // QBLOCK
    c = jnp.cumsum(log_f, axis=1).transpose(0, 2, 1)
    c_blocks = c.reshape(b, h, nb, QBLOCK).transpose(2, 0, 1, 3)
    kh = k.transpose(0, 2, 1, 3)
    vh = v.transpose(0, 2, 1, 3)
    key_pos = jnp.arange(s)
    scale = d ** -0.5

    def block(args):
        qb, cqb, i = args
        logits = jnp.einsum('bhqd,bhkd->bhqk', qb, kh).astype(jnp.float32) * scale
        logits = logits + cqb[..., :, None] - c[:, :, None, :]
        qpos = i * QBLOCK + jnp.arange(QBLOCK)
        mask = key_pos[None, :] <= qpos[:, None]
        probs = jax.nn.softmax(jnp.where(mask, logits, -jnp.inf), axis=-1)
        return jnp.einsum('bhqk,bhkd->bhqd', probs.astype(vh.dtype), vh)

    o = lax.map(block, (to_blocks(q), c_blocks, jnp.arange(nb)))
    return from_blocks(o)


def stick_breaking_attention(q, k, v):
    b, s, h, d = q.shape
    nb = s // QBLOCK
    kh = k.transpose(0, 2, 1, 3)
    vh = v.transpose(0, 2, 1, 3)
    key_pos = jnp.arange(s)
    scale = d ** -0.5

    def block(args):
        qb, i = args
        z = jnp.einsum('bhqd,bhkd->bhqk', qb, kh).astype(jnp.float32) * scale
        qpos = i * QBLOCK + jnp.arange(QBLOCK)
        mask = key_pos[None, :] < qpos[:, None]
        neg = jnp.where(mask, jax.nn.log_sigmoid(-z), 0.0)
        after = lax.cumsum(neg, axis=3, reverse=True) - neg
        a = jnp.where(mask, jnp.exp(jax.nn.log_sigmoid(z) + after), 0.0)
        return jnp.einsum('bhqk,bhkd->bhqd', a.astype(vh.dtype), vh)

    o = lax.map(block, (to_blocks(q), jnp.arange(nb)))
    return from_blocks(o)


def hierarchical_moe(h, w_group, w_expert, w_gate, w_up, w_down):
    b, s, d = h.shape
    t = b * s
    xt = h.reshape(t, d)
    g_logits = (xt @ w_group).astype(jnp.float32)
    g_prob = jax.nn.softmax(g_logits, axis=-1)
    g_sel = jnp.argmax(g_logits, axis=-1).astype(jnp.int32)
    p_group = jnp.take_along_axis(g_prob, g_sel[:, None], axis=1)
    e_logits = (xt @ w_expert).astype(jnp.float32).reshape(t, N_GROUPS, EXPERTS_PER_GROUP)
    e_logits = jnp.take_along_axis(e_logits, g_sel[:, None, None], axis=1)[:, 0]
    top_val, top_idx = lax.top_k(e_logits, TOP_K_IN_GROUP)
    gate = jax.nn.softmax(top_val, axis=-1) * p_group
    expert_id = g_sel[:, None] * EXPERTS_PER_GROUP + top_idx.astype(jnp.int32)

    m = t * TOP_K_IN_GROUP
    flat_e = expert_id.reshape(m)
    flat_tok = jnp.repeat(jnp.arange(t, dtype=jnp.int32), TOP_K_IN_GROUP)
    flat_w = gate.reshape(m)
    order = jnp.argsort(flat_e)
    se = flat_e[order]
    stok = flat_tok[order]
    sw = flat_w[order]
    counts = jnp.bincount(flat_e, length=N_EXPERTS)
    padded = (counts + MOE_BLOCK - 1) // MOE_BLOCK * MOE_BLOCK
    pad_end = jnp.cumsum(padded)
    pad_start = pad_end - padded
    start = jnp.cumsum(counts) - counts
    dest = pad_start[se] + jnp.arange(m) - start[se]
    n_blocks = m // MOE_BLOCK + N_EXPERTS
    p_rows = n_blocks * MOE_BLOCK
    row_tok = jnp.full((p_rows,), t, dtype=jnp.int32).at[dest].set(stok)
    row_w = jnp.zeros((p_rows,), dtype=gate.dtype).at[dest].set(sw)
    block_expert = jnp.minimum(
        jnp.searchsorted(pad_end, jnp.arange(n_blocks) * MOE_BLOCK, side='right'),
        N_EXPERTS - 1).astype(jnp.int32)
    x_pad = jnp.concatenate([xt, jnp.zeros((1, d), xt.dtype)], axis=0)
    xb = x_pad[row_tok].reshape(n_blocks, MOE_BLOCK, d)

    def expert_block(args):
        xe, e = args
        hid = jax.nn.silu(xe @ w_gate[e]) * (xe @ w_up[e])
        return hid @ w_down[e]

    yb = lax.map(expert_block, (xb, block_expert))
    y = jax.ops.segment_sum(yb.reshape(p_rows, d) * row_w[:, None].astype(yb.dtype),
                            row_tok, num_segments=t + 1)[:t]
    return y.reshape(b, s, d)


def setup_inputs(seed: int = 0) -> dict:
    key = jax.random.key(seed)
    ks = jax.random.split(key, 20)
    f32 = jnp.float32

    def nrm(k, shape, fan_in):
        return jax.random.normal(k, shape, f32) * (fan_in ** -0.5)

    def gain(k, shape):
        return 1.0 + 0.02 * jax.random.normal(k, shape, f32)

    return {
        'x': jax.random.normal(ks[0], (BATCH, SEQ, D_MODEL), f32),
        'p': jax.random.normal(ks[1], (DEPTH, BATCH, SEQ, D_PLE), f32),
        'w_in': nrm(ks[2], (DEPTH, D_MODEL, D_IN), D_MODEL),
        'b_forget': 1.0 + 3.0 * jax.random.uniform(ks[3], (DEPTH, N_HEADS_FOX), f32),
        'w_branch_fox': nrm(ks[4], (DEPTH, W_FOX, D_MODEL), W_FOX),
        'w_branch_sb': nrm(ks[5], (DEPTH, W_SB, D_MODEL), W_SB),
        'w_mix_out': nrm(ks[6], (DEPTH, D_MODEL, D_MODEL), D_MODEL),
        'g_mix': gain(ks[7], (DEPTH, D_MODEL)),
        'g_ffn': gain(ks[8], (DEPTH, D_MODEL)),
        'w_group': nrm(ks[9], (DEPTH, D_MODEL, N_GROUPS), D_MODEL),
        'w_expert': nrm(ks[10], (DEPTH, D_MODEL, N_EXPERTS), D_MODEL),
        'w_gate': nrm(ks[11], (DEPTH, N_EXPERTS, D_MODEL, D_EXPERT), D_MODEL),
        'w_up': nrm(ks[12], (DEPTH, N_EXPERTS, D_MODEL, D_EXPERT), D_MODEL),
        'w_down': nrm(ks[13], (DEPTH, N_EXPERTS, D_EXPERT, D_MODEL), D_EXPERT),
        'g_ple': gain(ks[14], (DEPTH, D_MODEL)),
        'w_ple_proj': nrm(ks[15], (DEPTH, D_PLE, D_MODEL), D_PLE),
        'w_ple_gate': nrm(ks[16], (DEPTH, D_MODEL, D_MODEL), D_MODEL),
        'g_final': gain(ks[17], (D_MODEL,)),
    }


def reference(x, p, w_in, b_forget, w_branch_fox, w_branch_sb, w_mix_out, g_mix, g_ffn,
              w_group, w_expert, w_gate, w_up, w_down, g_ple, w_ple_proj, w_ple_gate, g_final):
    b, s, _ = x.shape
    sizes = [W_FOX, W_FOX, W_FOX, N_HEADS_FOX, W_SB, W_SB, W_SB, D_MODEL]
    splits = [int(v) for v in np.cumsum(sizes)]
    for i in range(DEPTH):
        h = rmsnorm(x, g_mix[i])
        proj = h @ w_in[i]
        q_a, k_a, v_a, f_a, q_b, k_b, v_b, gate_a, gate_b = jnp.split(proj, splits, axis=-1)
        heads_a = (b, s, N_HEADS_FOX, HEAD_DIM)
        heads_b = (b, s, N_HEADS_SB, HEAD_DIM)
        log_f = jax.nn.log_sigmoid(f_a.astype(jnp.float32) + b_forget[i].astype(jnp.float32))
        o_a = forgetting_attention(q_a.reshape(heads_a), k_a.reshape(heads_a),
                                   v_a.reshape(heads_a), log_f)
        o_b = stick_breaking_attention(q_b.reshape(heads_b), k_b.reshape(heads_b),
                                       v_b.reshape(heads_b))
        mixed = (jax.nn.sigmoid(gate_a) * (o_a @ w_branch_fox[i])
                 + jax.nn.sigmoid(gate_b) * (o_b @ w_branch_sb[i]))
        x = x + mixed @ w_mix_out[i]
        x = x + hierarchical_moe(rmsnorm(x, g_ffn[i]), w_group[i], w_expert[i],
                                 w_gate[i], w_up[i], w_down[i])
        ple = p[i] @ w_ple_proj[i]
        x = x + jax.nn.sigmoid(rmsnorm(x, g_ple[i]) @ w_ple_gate[i]) * ple
    return rmsnorm(x, g_final)
```

```cpp
#include <hip/hip_runtime.h>
#include <hip/hip_cooperative_groups.h>
#include <cstdio>
#include <cstdint>
namespace cg = cooperative_groups;

#define LAS __attribute__((address_space(3)))
typedef unsigned short bf16_t;
typedef float f32x4 __attribute__((ext_vector_type(4)));
typedef unsigned u32x4 __attribute__((ext_vector_type(4)));
typedef unsigned u32x2 __attribute__((ext_vector_type(2)));

constexpr int NBATCH = 2, SEQ = 4096, T = NBATCH * SEQ, DM = 2048, NH = 8, HD = 128, WA = NH * HD;
constexpr int DIN = 10248, NPROJ = 10240, NQKV = 6144, DPLE = 256, NEXP = 32, DEXP = 512;
constexpr float EPS = 1e-6f;
constexpr float QK_SCALE = 0.08838834764831845f;
constexpr int NWAVES = 8, NTHREADS = NWAVES * 64;

constexpr size_t MiB = 1u << 20;
constexpr size_t WS_CTL = 0, CTL_BYTES = 64 * 1024;
constexpr size_t WS_LF = 1 * MiB;
constexpr size_t WS_CUM = WS_LF + 256 * 1024;
constexpr size_t WS_RS1 = WS_CUM + 256 * 1024;
constexpr size_t WS_RS2 = WS_RS1 + 32 * 1024;
constexpr size_t WS_GW = WS_RS2 + 32 * 1024;
constexpr size_t WS_NB = 1 * MiB + 768 * 1024;
constexpr size_t WS_LIST = 2 * MiB;
constexpr size_t WS_PB = 4 * MiB;
constexpr size_t WS_WTIN = 8 * MiB;
constexpr size_t WS_WTBF = WS_WTIN + 40 * MiB;
constexpr size_t WS_WTBS = WS_WTBF + 4 * MiB;
constexpr size_t WS_WTMIX = WS_WTBS + 4 * MiB;
constexpr size_t WS_WTPG = WS_WTMIX + 8 * MiB;
constexpr size_t WS_WTPP = WS_WTPG + 8 * MiB;
constexpr size_t WS_WTGU = WS_WTPP + 1 * MiB;
constexpr size_t WS_WTDN = WS_WTGU + 128 * MiB;
constexpr size_t WS_H = WS_WTDN + 64 * MiB;
constexpr size_t WS_OA = WS_H, WS_OB = WS_H + 16 * MiB;
constexpr size_t WS_QKV = WS_H + 32 * MiB;
constexpr size_t WS_MIXED = WS_QKV, WS_X1B = WS_QKV + 32 * MiB, WS_HID = WS_QKV + 64 * MiB;
constexpr size_t WS_GATES = WS_QKV + 96 * MiB;
constexpr size_t WS_YB = WS_GATES;
constexpr size_t WS_X1 = WS_GATES + 64 * MiB;
constexpr size_t WS_PLE = WS_X1 + 64 * MiB;
constexpr size_t WS_OA2 = WS_PLE + 32 * MiB;
constexpr size_t WS_LSE1 = WS_OA2 + 16 * MiB, WS_LSE2 = WS_LSE1 + 256 * 1024;
constexpr size_t WS_SS = WS_LSE2 + 256 * 1024;
constexpr size_t WS_WRH = WS_SS + 256 * 1024, WS_WRL = WS_WRH + 256 * 1024;
constexpr size_t WS_NSQ = WS_WRL + 256 * 1024;
constexpr size_t WS_END = WS_NSQ + 2 * MiB;
constexpr int CW_CNT = 64, CW_QHEAD = 128;

#ifndef PHASE_MASK
#define PHASE_MASK 0xFFFF
#endif
#define PH(k) ((PHASE_MASK >> (k)) & 1)
#ifndef FAST_MASK
#define FAST_MASK 0xFFFF
#endif
#define FAST(k) ((FAST_MASK >> (k)) & 1)
constexpr int LDS_BYTES = 147456;

__device__ __forceinline__ unsigned f2bf(float f) { unsigned u = __builtin_bit_cast(unsigned, f); return (u + 0x7fffu + ((u >> 16) & 1u)) >> 16; }
typedef float f32x2_g __attribute__((ext_vector_type(2)));
typedef __bf16 bf16x2_g __attribute__((ext_vector_type(2)));
__device__ __forceinline__ unsigned pk2(float lo, float hi) { f32x2_g v = {lo, hi}; bf16x2_g b = __builtin_convertvector(v, bf16x2_g); return __builtin_bit_cast(unsigned, b); }
__device__ __forceinline__ float bflo(unsigned w) { return __builtin_bit_cast(float, w << 16); }
__device__ __forceinline__ float bfhi(unsigned w) { return __builtin_bit_cast(float, w & 0xffff0000u); }
__device__ __forceinline__ float bf2f(bf16_t h) { return __builtin_bit_cast(float, (unsigned)h << 16); }
__device__ __forceinline__ float wave_sum(float v) {
#pragma unroll
    for (int o = 1; o < 64; o <<= 1) v += __shfl_xor(v, o);
    return v;
}
__device__ __forceinline__ float wave_max(float v) {
#pragma unroll
    for (int o = 1; o < 64; o <<= 1) v = fmaxf(v, __shfl_xor(v, o));
    return v;
}
__device__ __forceinline__ float logsig(float x) { return fminf(x, 0.f) - log1pf(expf(-fabsf(x))); }
__device__ __forceinline__ float sigmoidf(float x) { return 1.f / (1.f + expf(-x)); }
#define LDS_WAIT() asm volatile("s_waitcnt lgkmcnt(0)" ::: "memory")

struct Args {
    const float* in[18];
    float* out;
    unsigned char* ws;
};

__device__ __forceinline__ void tr_load(const float* W, int ldw, int k0, int srccol0, const float* kscale, f32x4 (&v)[8], f32x4& g0, f32x4& g1, int lane) {
    { const bool hs = kscale != nullptr; const float* kp = hs ? kscale + k0 + 8 * (lane & 7) : W;
      const f32x4 t0 = *(const f32x4*)kp, t1 = *(const f32x4*)(kp + 4); const f32x4 one = {1.f, 1.f, 1.f, 1.f};
      g0 = hs ? t0 : one; g1 = hs ? t1 : one; }
    const float* wp = W + (size_t)(k0 + (lane >> 3)) * ldw + srccol0 + 4 * (lane & 7);
#pragma unroll
    for (int i = 0; i < 8; ++i) v[i] = *(const f32x4*)(wp + (size_t)(8 * i) * ldw);
}
__device__ __forceinline__ void tr_finish(f32x4 (&v)[8], f32x4 g0, f32x4 g1, int K, bf16_t* WT, int k0, LAS float* scr, int lane) {
#pragma unroll
    for (int i = 0; i < 8; ++i) { LAS float* d = scr + (8 * i + (lane >> 3)) * 33 + 4 * (lane & 7); d[0] = v[i].x; d[1] = v[i].y; d[2] = v[i].z; d[3] = v[i].w; }
    LDS_WAIT(); asm volatile("" ::: "memory");
    const int c = lane & 7;
#pragma unroll
    for (int j = 0; j < 4; ++j) {
        const int n = (lane >> 3) + 8 * j; const LAS float* s = scr + (8 * c) * 33 + n;
        u32x4 o; o.x = pk2(s[0 * 33] * g0.x, s[1 * 33] * g0.y); o.y = pk2(s[2 * 33] * g0.z, s[3 * 33] * g0.w); o.z = pk2(s[4 * 33] * g1.x, s[5 * 33] * g1.y); o.w = pk2(s[6 * 33] * g1.z, s[7 * 33] * g1.w);
        *(u32x4*)(WT + (size_t)n * K + k0 + 8 * c) = o;
    }
    LDS_WAIT(); asm volatile("" ::: "memory");
}
__device__ __forceinline__ void tr_item(const float* W, int ldw, int K, const float* kscale, bf16_t* WT, int k0, int srccol0, LAS float* scr, int lane) {
    f32x4 v[8]; f32x4 g0, g1; tr_load(W, ldw, k0, srccol0, kscale, v, g0, g1, lane); tr_finish(v, g0, g1, K, WT, k0, scr, lane);
}

constexpr int I_GU1 = (DM / 64) * (1024 / 32), I_DN1 = (DEXP / 64) * (DM / 32), I_BR = (WA / 64) * (DM / 32), I_SQ = (DM / 64) * (DM / 32), I_IN = (DM / 64) * (NPROJ / 32), I_PP = (DPLE / 64) * (DM / 32);
constexpr int N_Q_ITEMS = NEXP * (I_GU1 + I_DN1) + 2 * I_BR + 2 * I_SQ, N_P0_ITEMS = I_IN + I_PP, CONV_CHUNK = 64, N_CONV_CHUNKS = N_Q_ITEMS / CONV_CHUNK;
static_assert(N_Q_ITEMS % (CONV_CHUNK * 8) == 0, "conversion chunks divide over the 8 XCD queues");
struct ConvP { const float* W; const float* ks; bf16_t* WT; int ldw, K, k0, col; };
__device__ __forceinline__ ConvP conv_params(const Args& a, int r) {
    unsigned char* ws = a.ws; ConvP p;
    if (r < NEXP * I_GU1) {
        const int e = r / I_GU1, q = r % I_GU1, nblk = 1024 / 32, kb = q / nblk, nb = q % nblk, n0 = 32 * nb;
        const int t = n0 >> 8, w = n0 & 255; const bool up = w >= 128;
        p.W = (up ? a.in[12] : a.in[11]) + (size_t)e * DM * DEXP; p.ks = a.in[8]; p.WT = (bf16_t*)(ws + WS_WTGU) + ((size_t)e * 1024 + n0) * DM; p.ldw = DEXP; p.K = DM; p.k0 = 64 * kb; p.col = t * 128 + (w & 127); return p; }
    r -= NEXP * I_GU1;
    if (r < NEXP * I_DN1) {
        const int e = r / I_DN1, q = r % I_DN1, nblk = DM / 32, kb = q / nblk, nb = q % nblk;
        p.W = a.in[13] + (size_t)e * DEXP * DM; p.ks = nullptr; p.WT = (bf16_t*)(ws + WS_WTDN) + ((size_t)e * DM + 32 * nb) * DEXP; p.ldw = DM; p.K = DEXP; p.k0 = 64 * kb; p.col = 32 * nb; return p; }
    r -= NEXP * I_DN1;
    const int nblk = DM / 32;
    if (r < 2 * I_BR) { const int z = r / I_BR, q = r % I_BR, kb = q / nblk, nb = q % nblk;
        p.W = z ? a.in[5] : a.in[4]; p.ks = nullptr; p.WT = (bf16_t*)(ws + (z ? WS_WTBS : WS_WTBF)) + (size_t)(32 * nb) * WA; p.ldw = DM; p.K = WA; p.k0 = 64 * kb; p.col = 32 * nb; return p; }
    r -= 2 * I_BR;
    if (r < 2 * I_SQ) { const int z = r / I_SQ, q = r % I_SQ, kb = q / nblk, nb = q % nblk;
        p.W = z ? a.in[16] : a.in[6]; p.ks = z ? a.in[14] : nullptr; p.WT = (bf16_t*)(ws + (z ? WS_WTPG : WS_WTMIX)) + (size_t)(32 * nb) * DM; p.ldw = DM; p.K = DM; p.k0 = 64 * kb; p.col = 32 * nb; return p; }
    r -= 2 * I_SQ;
    if (r < I_IN) { const int nb2 = NPROJ / 32, kb = r / nb2, nb = r % nb2, n0 = 32 * nb;
        p.W = a.in[2]; p.ks = a.in[7]; p.WT = (bf16_t*)(ws + WS_WTIN) + (size_t)n0 * DM; p.ldw = DIN; p.K = DM; p.k0 = 64 * kb; p.col = n0 < 3072 ? n0 : n0 + 8; return p; }
    r -= I_IN;
    { const int kb = r / nblk, nb = r % nblk;
      p.W = a.in[15]; p.ks = nullptr; p.WT = (bf16_t*)(ws + WS_WTPP) + (size_t)(32 * nb) * DPLE; p.ldw = DM; p.K = DPLE; p.k0 = 64 * kb; p.col = 32 * nb; }
    return p;
}
__device__ __forceinline__ void conv_wave(const Args& a, int r0, int stride, int cnt, LAS float* scr, int lane) {
    f32x4 va[8], vb[8]; f32x4 ga0, ga1, gb0, gb1;
    ConvP pa, pb;
#define CV_LOAD(P, V, G0, G1, idx) do { P = conv_params(a, r0 + (idx) * stride); tr_load(P.W, P.ldw, P.k0, P.col, P.ks, V, G0, G1, lane); } while (0)
#define CV_FIN(P, V, G0, G1) tr_finish(V, G0, G1, P.K, P.WT, P.k0, scr, lane)
    if (cnt > 0) CV_LOAD(pa, va, ga0, ga1, 0);
#pragma unroll 1
    for (int q = 0; q < cnt; q += 2) {
        if (q + 1 < cnt) CV_LOAD(pb, vb, gb0, gb1, q + 1);
        CV_FIN(pa, va, ga0, ga1);
        if (q + 2 < cnt) CV_LOAD(pa, va, ga0, ga1, q + 2);
        if (q + 1 < cnt) CV_FIN(pb, vb, gb0, gb1);
    }
#undef CV_LOAD
#undef CV_FIN
}

__device__ __forceinline__ void p0_prologue(const Args& a, LAS unsigned char* lds, int gw, int NGW, int wave, int lane, int tid) {
    unsigned char* ws = a.ws;
    LAS float* scr = (LAS float*)(lds + wave * 8704);
    LAS float* wf = (LAS float*)(lds + 72 * 1024);
    const float* w_in = a.in[2]; const float* g_mix = a.in[7];
    for (int k = tid; k < DM; k += NTHREADS) { const float g = g_mix[k]; const f32x4 w0 = *(const f32x4*)(w_in + (size_t)k * DIN + 3072), w1 = *(const f32x4*)(w_in + (size_t)k * DIN + 3076);
        wf[0 * DM + k] = g * w0.x; wf[1 * DM + k] = g * w0.y; wf[2 * DM + k] = g * w0.z; wf[3 * DM + k] = g * w0.w; wf[4 * DM + k] = g * w1.x; wf[5 * DM + k] = g * w1.y; wf[6 * DM + k] = g * w1.z; wf[7 * DM + k] = g * w1.w; }
    { const int n = (N_P0_ITEMS - gw + NGW - 1) / NGW; if (n > 0) conv_wave(a, N_Q_ITEMS + gw, NGW, n, scr, lane); }
    __syncthreads();
    const float* x = a.in[0]; const float* b_forget = a.in[3];
    bf16_t* H = (bf16_t*)(ws + WS_H); float* LF = (float*)(ws + WS_LF);
    for (int m = gw; m < T; m += NGW) {
        const f32x4* xr = (const f32x4*)(x + (size_t)m * DM) + lane;
        float ss = 0.f;
#pragma unroll
        for (int j = 0; j < 8; ++j) { const f32x4 t = xr[64 * j]; ss += (t.x * t.x + t.y * t.y) + (t.z * t.z + t.w * t.w); }
        ss = wave_sum(ss);
        const float rstd = 1.0f / sqrtf(ss * (1.0f / DM) + EPS);
        u32x2* h8 = (u32x2*)(H + (size_t)m * DM) + lane;
        float f0 = 0, f1 = 0, f2 = 0, f3 = 0, f4 = 0, f5 = 0, f6 = 0, f7 = 0;
#pragma unroll 1
        for (int j = 0; j < 8; ++j) {
            const f32x4 v = xr[64 * j] * rstd;
            u32x2 o; o.x = pk2(v.x, v.y); o.y = pk2(v.z, v.w); h8[64 * j] = o;
            const LAS float* wp = wf + 256 * j + 4 * lane;
            const f32x4 a0 = *(const LAS f32x4*)(wp + 0 * DM), a1 = *(const LAS f32x4*)(wp + 1 * DM), a2 = *(const LAS f32x4*)(wp + 2 * DM), a3 = *(const LAS f32x4*)(wp + 3 * DM);
            const f32x4 a4 = *(const LAS f32x4*)(wp + 4 * DM), a5 = *(const LAS f32x4*)(wp + 5 * DM), a6 = *(const LAS f32x4*)(wp + 6 * DM), a7 = *(const LAS f32x4*)(wp + 7 * DM);
            f0 += v.x * a0.x + v.y * a0.y + v.z * a0.z + v.w * a0.w; f1 += v.x * a1.x + v.y * a1.y + v.z * a1.z + v.w * a1.w;
            f2 += v.x * a2.x + v.y * a2.y + v.z * a2.z + v.w * a2.w; f3 += v.x * a3.x + v.y * a3.y + v.z * a3.z + v.w * a3.w;
            f4 += v.x * a4.x + v.y * a4.y + v.z * a4.z + v.w * a4.w; f5 += v.x * a5.x + v.y * a5.y + v.z * a5.z + v.w * a5.w;
            f6 += v.x * a6.x + v.y * a6.y + v.z * a6.z + v.w * a6.w; f7 += v.x * a7.x + v.y * a7.y + v.z * a7.z + v.w * a7.w;
        }
        f0 = wave_sum(f0); f1 = wave_sum(f1); f2 = wave_sum(f2); f3 = wave_sum(f3); f4 = wave_sum(f4); f5 = wave_sum(f5); f6 = wave_sum(f6); f7 = wave_sum(f7);
        float sel = f0; sel = lane == 1 ? f1 : sel; sel = lane == 2 ? f2 : sel; sel = lane == 3 ? f3 : sel; sel = lane == 4 ? f4 : sel; sel = lane == 5 ? f5 : sel; sel = lane == 6 ? f6 : sel; sel = lane == 7 ? f7 : sel;
        if (lane < 8) LF[(size_t)m * 8 + lane] = logsig(sel + b_forget[lane]);
    }
    { const float* g_ffn = a.in[8]; const float* w_group = a.in[9]; const float* w_expert = a.in[10]; bf16_t* WRH = (bf16_t*)(ws + WS_WRH); bf16_t* WRL = (bf16_t*)(ws + WS_WRL);
      for (int idx = gw * 64 + lane; idx < 48 * DM; idx += NGW * 64) { const int c = idx / DM, k = idx % DM;
          const float v = c < 32 ? w_expert[(size_t)k * 32 + c] * g_ffn[k] : (c < 36 ? w_group[(size_t)k * 4 + (c - 32)] * g_ffn[k] : 0.f);
          const unsigned h = f2bf(v); const float r = v - __builtin_bit_cast(float, h << 16);
          WRH[idx] = (bf16_t)h; WRL[idx] = (bf16_t)f2bf(r); } }
    const float* p = a.in[1]; bf16_t* PB = (bf16_t*)(ws + WS_PB);
    for (int i = gw * 64 + lane; i < T * DPLE / 4; i += NGW * 64) {
        const f32x4 v = ((const f32x4*)p)[i]; u32x2 o; o.x = pk2(v.x, v.y); o.y = pk2(v.z, v.w); ((u32x2*)PB)[i] = o;
    }
    __syncthreads();
}

__device__ __forceinline__ void p_cumsum(const Args& a, LAS float* ldsf, int bid, int wave, int lane, int tid) {
    if (bid >= NBATCH) return;
    const float* LF = (const float*)(a.ws + WS_LF) + ((size_t)bid * SEQ + 8 * tid) * 8; float* CUM = (float*)(a.ws + WS_CUM); float* NBp = (float*)(a.ws + WS_NB);
    f32x4 v[8][2];
#pragma unroll
    for (int t = 0; t < 8; ++t) { v[t][0] = *(const f32x4*)(LF + t * 8); v[t][1] = *(const f32x4*)(LF + t * 8 + 4); }
#pragma unroll
    for (int t = 1; t < 8; ++t) { v[t][0] += v[t - 1][0]; v[t][1] += v[t - 1][1]; }
    f32x4 tot0 = v[7][0], tot1 = v[7][1], inc0 = tot0, inc1 = tot1;
#pragma unroll
    for (int o = 1; o < 64; o <<= 1) {
#pragma unroll
        for (int i = 0; i < 4; ++i) { const float u0 = __shfl_up(inc0[i], o), u1 = __shfl_up(inc1[i], o); if (lane >= o) { inc0[i] += u0; inc1[i] += u1; } } }
    if (lane == 63) { *(LAS f32x4*)(ldsf + wave * 8) = inc0; *(LAS f32x4*)(ldsf + wave * 8 + 4) = inc1; }
    __syncthreads();
    f32x4 off0 = inc0 - tot0, off1 = inc1 - tot1;
    for (int w = 0; w < wave; ++w) { off0 += *(LAS const f32x4*)(ldsf + w * 8); off1 += *(LAS const f32x4*)(ldsf + w * 8 + 4); }
    constexpr float NS = -1.0f / QK_SCALE;
#pragma unroll
    for (int h = 0; h < 8; ++h) {
        f32x4 c0, c1;
#pragma unroll
        for (int t = 0; t < 4; ++t) { c0[t] = (h < 4 ? v[t][0][h & 3] + off0[h & 3] : v[t][1][h & 3] + off1[h & 3]); c1[t] = (h < 4 ? v[t + 4][0][h & 3] + off0[h & 3] : v[t + 4][1][h & 3] + off1[h & 3]); }
        float* dc = CUM + (size_t)(bid * NH + h) * SEQ + 8 * tid; float* dn = NBp + (size_t)(bid * NH + h) * SEQ + 8 * tid;
        *(f32x4*)dc = c0; *(f32x4*)(dc + 4) = c1; *(f32x4*)dn = c0 * NS; *(f32x4*)(dn + 4) = c1 * NS;
    }
    __syncthreads();
}

constexpr int GBM = 128, GBN = 64, GBK = 32, LDA_S = 132, LDB_S = 68;
template <int NP, class Epi>
__device__ __forceinline__ void base_gemm_tile(const bf16_t* A0, const bf16_t* A1, int lda, const int* rowlist, int rshift, int nvalid,
                                               const bf16_t* B0, const bf16_t* B1, int ldb, int K, int m0, int n0, LAS float* lds, const Epi& epi) {
    const int tid = threadIdx.x, tm = tid >> 4, tn = tid & 15;
    LAS float* As = lds;
    LAS float* Bs = lds + NP * GBK * LDA_S;
    f32x4 acc[NP][4];
#pragma unroll
    for (int p = 0; p < NP; ++p)
#pragma unroll
        for (int i = 0; i < 4; ++i) acc[p][i] = (f32x4){0.f, 0.f, 0.f, 0.f};
    const int lr = tid >> 2, kc = (tid & 3) * 8;
    int ar = m0 + lr; if (ar > nvalid - 1) ar = nvalid - 1;
    if (rowlist) ar = rowlist[ar] >> rshift;
    for (int k0 = 0; k0 < K; k0 += GBK) {
#pragma unroll
        for (int p = 0; p < NP; ++p) {
            const bf16_t* Ap = p == 0 ? A0 : A1; const bf16_t* Bp = p == 0 ? B0 : B1;
            { const u32x4 w = *(const u32x4*)(Ap + (size_t)ar * lda + k0 + kc); LAS float* d = As + p * GBK * LDA_S + kc * LDA_S + lr;
              d[0 * LDA_S] = bflo(w.x); d[1 * LDA_S] = bfhi(w.x); d[2 * LDA_S] = bflo(w.y); d[3 * LDA_S] = bfhi(w.y);
              d[4 * LDA_S] = bflo(w.z); d[5 * LDA_S] = bfhi(w.z); d[6 * LDA_S] = bflo(w.w); d[7 * LDA_S] = bfhi(w.w); }
            if (tid < 256) { const u32x4 w = *(const u32x4*)(Bp + (size_t)(n0 + lr) * ldb + k0 + kc); LAS float* d = Bs + p * GBK * LDB_S + kc * LDB_S + lr;
              d[0 * LDB_S] = bflo(w.x); d[1 * LDB_S] = bfhi(w.x); d[2 * LDB_S] = bflo(w.y); d[3 * LDB_S] = bfhi(w.y);
              d[4 * LDB_S] = bflo(w.z); d[5 * LDB_S] = bfhi(w.z); d[6 * LDB_S] = bflo(w.w); d[7 * LDB_S] = bfhi(w.w); }
        }
        __syncthreads();
#pragma unroll
        for (int p = 0; p < NP; ++p) {
#pragma unroll 8
            for (int k = 0; k < GBK; ++k) {
                const f32x4 av = *(const LAS f32x4*)(As + p * GBK * LDA_S + k * LDA_S + tm * 4);
                const f32x4 bv = *(const LAS f32x4*)(Bs + p * GBK * LDB_S + k * LDB_S + tn * 4);
                acc[p][0] += av.x * bv; acc[p][1] += av.y * bv; acc[p][2] += av.z * bv; acc[p][3] += av.w * bv;
            }
        }
        __syncthreads();
    }
#pragma unroll
    for (int i = 0; i < 4; ++i) { const int m = m0 + tm * 4 + i; if (m < nvalid) epi(m, n0 + tn * 4, acc[0][i], acc[NP - 1][i]); }
}

__device__ __forceinline__ void st_bf4(bf16_t* p, f32x4 v) { u32x2 o; o.x = pk2(v.x, v.y); o.y = pk2(v.z, v.w); *(u32x2*)p = o; }
__device__ __forceinline__ f32x4 ld_bf4(const bf16_t* p) { const u32x2 w = *(const u32x2*)p; return (f32x4){bflo(w.x), bfhi(w.x), bflo(w.y), bfhi(w.y)}; }


namespace pg8 {
typedef short bf16x8 __attribute__((ext_vector_type(8)));
constexpr int BM = 256, BK = 64, HALF = 128, HTB = HALF * BK * 2, STAGE_BYTES = 8 * HTB, NXCD = 8, WGM = 8;
__device__ __forceinline__ int lds_byte(int r, int c) { const int st = (r >> 4) * 2 + (c >> 5), rr = r & 15, cc = c & 31, ob = rr * 64 + cc * 2; return st * 1024 + (ob ^ (((ob >> 9) & 1) << 5)); }
__device__ __forceinline__ void stage_rc(int b, int& R, int& C) { const int st = b / 1024, sb = b % 1024, swz = sb ^ (((sb >> 9) & 1) << 5); R = (st >> 1) * 16 + swz / 64; C = (st & 1) * 32 + (swz % 64) / 2; }
__device__ __forceinline__ int perm32(int rho) { const int n = rho >> 4, i = rho & 15; return 8 * (i >> 2) + 4 * n + (i & 3); }
struct Unit { int pm, pn, z; };
struct Gemm { const bf16_t* A[2]; const bf16_t* Bt[2]; int K; };
typedef float f32x2_t __attribute__((ext_vector_type(2))); typedef __bf16 bf16x2_t __attribute__((ext_vector_type(2)));
__device__ __forceinline__ unsigned cvt_pk_bf16(float lo, float hi) { f32x2_t v = {lo, hi}; bf16x2_t b = __builtin_convertvector(v, bf16x2_t); return __builtin_bit_cast(unsigned, b); }
__device__ __forceinline__ u32x4 pack8(f32x4 a, f32x4 b) { u32x4 w; w.x = cvt_pk_bf16(a[0], a[1]); w.y = cvt_pk_bf16(a[2], a[3]); w.z = cvt_pk_bf16(b[0], b[1]); w.w = cvt_pk_bf16(b[2], b[3]); return w; }

template <int Z> struct DenseOrder {
    int nM, nN, nwg, G, c;
    __device__ void init(int M, int N, int G_, int c_) { nM = M / BM; nN = N / BM; nwg = nM * nN; G = G_; c = c_; }
    __device__ __forceinline__ bool next(int i, Unit& u) const {
        const long L = (long)(i / Z) * G + c; if (L >= nwg) return false;
        int wgid = (int)L; { const int q = nwg / NXCD, r = nwg % NXCD, xcd = wgid % NXCD, off = wgid / NXCD; wgid = (xcd < r ? xcd * (q + 1) : r * (q + 1) + (xcd - r) * q) + off; }
        const int nig = WGM * nN, gid = wgid / nig, fm = gid * WGM, gsz = (nM - fm) < WGM ? (nM - fm) : WGM;
        u.pm = fm + ((wgid % nig) % gsz); u.pn = (wgid % nig) / gsz; u.z = i % Z; return true;
    }
    __device__ __forceinline__ int tok(int, int) const { return 0; }
};

template <class Epi, class Sched, bool GATHER>
__device__ __forceinline__ void gemm_phase(LAS unsigned char* lds, const Gemm g, const Sched& S, const Epi& E) {
    int tid = threadIdx.x; asm volatile("" : "+v"(tid));
    const int wid = __builtin_amdgcn_readfirstlane(tid >> 6), lane = tid & 63, wr = wid >> 2, wc = wid & 3, fr = lane & 15, fq = lane >> 4;
    const int K = g.K, nt = K / BK;
    unsigned voffB[2];
#pragma unroll
    for (int i = 0; i < 2; ++i) { int sR, sC; stage_rc(tid * 16 + i * 8192, sR, sC); const int Rb = (sR & ~31) + perm32(sR & 31); voffB[i] = (unsigned)(Rb * K + sC) * 2u; }
    const size_t kstep = (size_t)(BK * 2);
    const size_t hstep = (size_t)HALF * K * 2;
    const size_t tstep = 2 * hstep;
    const unsigned ldsw = (unsigned)wid * 1024u;
    const int aoff = lds_byte(wr * 64 + fr, fq * 8), boff = lds_byte(wc * 32 + fr, fq * 8);
#define PG8_SA(b, h) (((b) * 2 + (h)) * HTB)
#define PG8_SB(b, h) ((4 + (b) * 2 + (h)) * HTB)
#define PG8_STAGE2(bufoff, gbase, o0, o1) do { \
        __builtin_amdgcn_global_load_lds((const unsigned*)((const char*)(gbase) + (o0)), (LAS unsigned*)(lds + (bufoff) + ldsw), 16, 0, 0); \
        __builtin_amdgcn_global_load_lds((const unsigned*)((const char*)(gbase) + (o1)), (LAS unsigned*)(lds + (bufoff) + ldsw + 8192), 16, 0, 0); } while (0)
#define PG8_STAGEB(bufoff, gbase) PG8_STAGE2(bufoff, gbase, voffB[0], voffB[1])
#define PG8_LDA(dst, b, h) do { _Pragma("unroll") for (int m = 0; m < 4; ++m) _Pragma("unroll") for (int k = 0; k < 2; ++k) dst[m][k] = *(const LAS bf16x8*)(lds + PG8_SA(b, h) + aoff + m * 2048 + k * 1024); } while (0)
#define PG8_LDB(dst, b, h) do { _Pragma("unroll") for (int n = 0; n < 2; ++n) _Pragma("unroll") for (int k = 0; k < 2; ++k) dst[n][k] = *(const LAS bf16x8*)(lds + PG8_SB(b, h) + boff + n * 2048 + k * 1024); } while (0)
#define PG8_MMA(ai, bj, At, Bt) do { __builtin_amdgcn_s_setprio(1); _Pragma("unroll") for (int m = 0; m < 4; ++m) _Pragma("unroll") for (int n = 0; n < 2; ++n) _Pragma("unroll") for (int k = 0; k < 2; ++k) \
        acc[ai][bj][m][n] = __builtin_amdgcn_mfma_f32_16x16x32_bf16(Bt[n][k], At[m][k], acc[ai][bj][m][n], 0, 0, 0); __builtin_amdgcn_s_setprio(0); } while (0)
#ifdef PG8_CONSERVATIVE
#define PG8_WAIT_V(n) asm volatile("s_waitcnt vmcnt(0)" ::: "memory")
#else
#define PG8_WAIT_V(n) asm volatile("s_waitcnt vmcnt(" #n ")" ::: "memory")
#endif
#define PG8_WAIT_L(n) asm volatile("s_waitcnt lgkmcnt(" #n ")" ::: "memory")
#define PG8_BAR __builtin_amdgcn_s_barrier()
#define PG8_SCHED __builtin_amdgcn_sched_barrier(0)
#define PG8_AOFFS(dst, ui_) do { int t_ = threadIdx.x; asm volatile("" : "+v"(t_)); _Pragma("unroll") for (int i = 0; i < 2; ++i) { int R_, C_; stage_rc(t_ * 16 + i * 8192, R_, C_); \
        _Pragma("unroll") for (int h = 0; h < 2; ++h) { \
        if constexpr (GATHER) dst[h][i] = ((unsigned)S.tok(ui_, h * HALF + R_) * (unsigned)K + (unsigned)C_) * 2u; \
        else dst[h][i] = (unsigned)((h * HALF + R_) * K + C_) * 2u; } } } while (0)
    Unit cur, nxt; int ui = 0;
    if (!S.next(0, cur)) return;
    f32x4 acc[2][2][4][2];
#pragma unroll
    for (int a = 0; a < 2; ++a)
#pragma unroll
        for (int b = 0; b < 2; ++b)
#pragma unroll
            for (int m = 0; m < 4; ++m)
#pragma unroll
                for (int n = 0; n < 2; ++n) acc[a][b][m][n] = (f32x4){0.f, 0.f, 0.f, 0.f};
    bf16x8 At[4][2], B0[2][2], B1[2][2];
    unsigned vA[2][2];
    PG8_AOFFS(vA, 0);
    const char* cA = (const char*)(cur.z ? g.A[1] : g.A[0]) + (GATHER ? (size_t)0 : (size_t)cur.pm * tstep); const char* cB = (const char*)(cur.z ? g.Bt[1] : g.Bt[0]) + (size_t)cur.pn * tstep;
    PG8_STAGEB(PG8_SB(0, 0), cB); PG8_STAGEB(PG8_SB(0, 1), cB + hstep); PG8_STAGE2(PG8_SA(0, 0), cA, vA[0][0], vA[0][1]); PG8_STAGE2(PG8_SA(0, 1), cA, vA[1][0], vA[1][1]);
    if (wr == 1) PG8_BAR;
    PG8_WAIT_V(2); PG8_BAR;
    PG8_STAGEB(PG8_SB(1, 0), cB + kstep); PG8_STAGE2(PG8_SA(1, 0), cA + kstep, vA[0][0], vA[0][1]); PG8_STAGEB(PG8_SB(1, 1), cB + hstep + kstep);
    PG8_WAIT_V(6); PG8_BAR;
    for (;;) {
        const bool has_next = S.next(ui + 1, nxt);
        const char* nA = has_next ? (const char*)(nxt.z ? g.A[1] : g.A[0]) + (GATHER ? (size_t)0 : (size_t)nxt.pm * tstep) : cA; const char* nB = has_next ? (const char*)(nxt.z ? g.Bt[1] : g.Bt[0]) + (size_t)nxt.pn * tstep : cB;
#pragma unroll 1
        for (int t = 0; t < nt; t += 2) {
            const bool last = (t == nt - 2);
            const char* a1 = cA + (size_t)(t + 1) * kstep;
            const char* a2 = last ? nA : cA + (size_t)(t + 2) * kstep; const char* b2 = last ? nB : cB + (size_t)(t + 2) * kstep;
            const char* a3 = a2 + kstep; const char* b3 = b2 + kstep;
            unsigned v2[2][2];
#pragma unroll
            for (int h = 0; h < 2; ++h)
#pragma unroll
                for (int i = 0; i < 2; ++i) v2[h][i] = vA[h][i];
            if constexpr (GATHER) { if (last && has_next) { PG8_AOFFS(v2, ui + 1); } }
            PG8_LDB(B0, 0, 0); PG8_LDB(B1, 0, 1); PG8_SCHED; PG8_LDA(At, 0, 0); PG8_STAGE2(PG8_SA(1, 1), a1, vA[1][0], vA[1][1]);
            PG8_WAIT_V(8); PG8_WAIT_L(0); PG8_BAR; PG8_MMA(0, 0, At, B0); PG8_MMA(0, 1, At, B1); PG8_BAR; PG8_SCHED;
            PG8_LDA(At, 0, 1); PG8_STAGEB(PG8_SB(0, 0), b2); PG8_STAGEB(PG8_SB(0, 1), b2 + hstep); PG8_STAGE2(PG8_SA(0, 0), a2, v2[0][0], v2[0][1]);
            PG8_WAIT_V(8); PG8_WAIT_L(0); PG8_BAR; PG8_MMA(1, 0, At, B0); PG8_MMA(1, 1, At, B1); PG8_BAR; PG8_SCHED;
            PG8_LDB(B0, 1, 0); PG8_LDB(B1, 1, 1); PG8_SCHED; PG8_LDA(At, 1, 0); PG8_STAGE2(PG8_SA(0, 1), a2, v2[1][0], v2[1][1]);
            PG8_WAIT_V(8); PG8_WAIT_L(0); PG8_BAR; PG8_MMA(0, 0, At, B0); PG8_MMA(0, 1, At, B1); PG8_BAR; PG8_SCHED;
            PG8_LDA(At, 1, 1); PG8_STAGEB(PG8_SB(1, 0), b3); PG8_STAGEB(PG8_SB(1, 1), b3 + hstep); PG8_STAGE2(PG8_SA(1, 0), a3, v2[0][0], v2[0][1]);
            PG8_WAIT_V(8); PG8_WAIT_L(0); PG8_BAR; PG8_MMA(1, 0, At, B0); PG8_MMA(1, 1, At, B1); PG8_BAR; PG8_SCHED;
        }
        if (wr == 0) PG8_BAR;
        { int l2 = threadIdx.x; asm volatile("" : "+v"(l2)); E(acc, cur, ui, wr, wc, l2 & 15, (l2 >> 4) & 3, lds); }
        if (!has_next) break;
#pragma unroll
        for (int a = 0; a < 2; ++a)
#pragma unroll
            for (int b = 0; b < 2; ++b)
#pragma unroll
                for (int m = 0; m < 4; ++m)
#pragma unroll
                    for (int n = 0; n < 2; ++n) acc[a][b][m][n] = (f32x4){0.f, 0.f, 0.f, 0.f};
        cur = nxt; cA = nA; cB = nB; ++ui;
        if constexpr (GATHER) { PG8_AOFFS(vA, ui); }
        if (wr == 1) PG8_BAR;
    }
    PG8_WAIT_V(0);
    PG8_BAR;
#undef PG8_SA
#undef PG8_SB
#undef PG8_STAGE2
#undef PG8_STAGEB
#undef PG8_LDA
#undef PG8_LDB
#undef PG8_MMA
#undef PG8_WAIT_V
#undef PG8_WAIT_L
#undef PG8_BAR
#undef PG8_SCHED
#undef PG8_AOFFS
}
}


__device__ __forceinline__ float fast_sigmoid(float x) { return __builtin_amdgcn_rcpf(1.f + __builtin_amdgcn_exp2f(-1.4426950408889634f * x)); }
#define EPI_ROWS_BEGIN  _Pragma("unroll") for (int ai = 0; ai < 2; ++ai) _Pragma("unroll") for (int m = 0; m < 4; ++m) { const int rl_ = ai * 128 + wr * 64 + m * 16 + fr;
#define EPI_ROWS_END    asm volatile("" ::: "memory"); }
#define EPI_RL(it) (((it) >> 2) * 128 + wr * 64 + ((it) & 3) * 16 + fr)
#define EPI_PIPE(LOADS, USES) do { LOADS(0, 0); _Pragma("unroll") for (int it_ = 0; it_ < 8; ++it_) { if (it_ + 1 < 8) { LOADS(it_ + 1, (it_ + 1) & 1); } USES(it_, it_ & 1); asm volatile("" ::: "memory"); } } while (0)
typedef f32x4 acc_t[2][2][4][2];

struct EpiP1 {
    bf16_t* QKV; bf16_t* GATES; float* NSQ;
    __device__ __forceinline__ void operator()(const acc_t& acc, const pg8::Unit& u, int, int wr, int wc, int fr, int fq, LAS unsigned char*) const {
        const int colt = u.pn * 256 + wc * 32 + 8 * fq;
        if (u.pn < 8) {
            EPI_ROWS_BEGIN const size_t row = (size_t)u.pm * 256 + rl_;
#pragma unroll
                for (int bj = 0; bj < 2; ++bj) { const f32x4 x0 = acc[ai][bj][m][0], x1 = acc[ai][bj][m][1];
                    *(u32x4*)(QKV + row * NQKV + colt + bj * 128) = pg8::pack8(x0, x1);
                    float sq = x0[0] * x0[0] + x0[1] * x0[1] + x0[2] * x0[2] + x0[3] * x0[3] + x1[0] * x1[0] + x1[1] * x1[1] + x1[2] * x1[2] + x1[3] * x1[3];
                    sq += __builtin_bit_cast(float, __builtin_amdgcn_ds_swizzle(__builtin_bit_cast(int, sq), 0x1F | (16 << 10)));
                    { auto rr = __builtin_amdgcn_permlane32_swap(__float_as_uint(sq), __float_as_uint(sq), false, false); sq = __uint_as_float(rr[0]) + __uint_as_float(rr[1]); }
                    if (fq == 0) NSQ[(size_t)((u.pn * 2 + bj) * 4 + wc) * T + row] = sq; }
            EPI_ROWS_END
        } else if (u.pn < 24) {
            EPI_ROWS_BEGIN const size_t row = (size_t)u.pm * 256 + rl_;
#pragma unroll
                for (int bj = 0; bj < 2; ++bj) *(u32x4*)(QKV + row * NQKV + colt + bj * 128) = pg8::pack8(acc[ai][bj][m][0], acc[ai][bj][m][1]);
            EPI_ROWS_END
        } else {
            EPI_ROWS_BEGIN const size_t row = (size_t)u.pm * 256 + rl_;
#pragma unroll
                for (int bj = 0; bj < 2; ++bj) { f32x4 a = acc[ai][bj][m][0], b = acc[ai][bj][m][1];
#pragma unroll
                    for (int i = 0; i < 4; ++i) { a[i] = fast_sigmoid(a[i]); b[i] = fast_sigmoid(b[i]); }
                    *(u32x4*)(GATES + row * 4096 + (colt - NQKV) + bj * 128) = pg8::pack8(a, b); }
            EPI_ROWS_END
        }
    }
};
struct EpiStoreBf {
    bf16_t* C; int ldc;
    __device__ __forceinline__ void operator()(const acc_t& acc, const pg8::Unit& u, int, int wr, int wc, int fr, int fq, LAS unsigned char*) const {
        const int colt = u.pn * 256 + wc * 32 + 8 * fq;
        EPI_ROWS_BEGIN const size_t row = (size_t)u.pm * 256 + rl_;
#pragma unroll
            for (int bj = 0; bj < 2; ++bj) *(u32x4*)(C + row * ldc + colt + bj * 128) = pg8::pack8(acc[ai][bj][m][0], acc[ai][bj][m][1]);
        EPI_ROWS_END
    }
};
__device__ __forceinline__ void unpack8(u32x4 w, f32x4& a, f32x4& b) { a = (f32x4){bflo(w.x), bfhi(w.x), bflo(w.y), bfhi(w.y)}; b = (f32x4){bflo(w.z), bfhi(w.z), bflo(w.w), bfhi(w.w)}; }
struct EpiP3 {
    const bf16_t* GATES; bf16_t* MIXED;
    __device__ __forceinline__ void operator()(const acc_t& acc, const pg8::Unit& u, int, int wr, int wc, int fr, int fq, LAS unsigned char*) const {
        const int colt = u.pn * 256 + wc * 32 + 8 * fq;
        u32x4 G_[2][2], M_[2][2];
#define P3_LOADS(it, sl) do { const size_t row = (size_t)u.pm * 256 + EPI_RL(it); _Pragma("unroll") for (int bj = 0; bj < 2; ++bj) { const int col = colt + bj * 128; \
            G_[sl][bj] = *(const u32x4*)(GATES + row * 4096 + u.z * 2048 + col); if (u.z == 1) M_[sl][bj] = *(const u32x4*)(MIXED + row * DM + col); } } while (0)
#define P3_USES(it, sl) do { const size_t row = (size_t)u.pm * 256 + EPI_RL(it); const int ai = (it) >> 2, m = (it) & 3; _Pragma("unroll") for (int bj = 0; bj < 2; ++bj) { const int col = colt + bj * 128; \
            f32x4 g0, g1; unpack8(G_[sl][bj], g0, g1); f32x4 r0 = g0 * acc[ai][bj][m][0], r1 = g1 * acc[ai][bj][m][1]; \
            if (u.z == 1) { f32x4 p0, p1; unpack8(M_[sl][bj], p0, p1); r0 += p0; r1 += p1; } \
            *(u32x4*)(MIXED + row * DM + col) = pg8::pack8(r0, r1); } } while (0)
        EPI_PIPE(P3_LOADS, P3_USES);
#undef P3_LOADS
#undef P3_USES
    }
};
struct EpiP4 {
    const float* x; float* X1; bf16_t* X1B;
    __device__ __forceinline__ void operator()(const acc_t& acc, const pg8::Unit& u, int, int wr, int wc, int fr, int fq, LAS unsigned char*) const {
        const int colt = u.pn * 256 + wc * 32 + 8 * fq;
        f32x4 X_[2][2][2];
#define P4_LOADS(it, sl) do { const size_t row = (size_t)u.pm * 256 + EPI_RL(it); _Pragma("unroll") for (int bj = 0; bj < 2; ++bj) { const size_t o = row * DM + colt + bj * 128; \
            X_[sl][bj][0] = *(const f32x4*)(x + o); X_[sl][bj][1] = *(const f32x4*)(x + o + 4); } } while (0)
#define P4_USES(it, sl) do { const size_t row = (size_t)u.pm * 256 + EPI_RL(it); const int ai = (it) >> 2, m = (it) & 3; _Pragma("unroll") for (int bj = 0; bj < 2; ++bj) { const size_t o = row * DM + colt + bj * 128; \
            const f32x4 r0 = X_[sl][bj][0] + acc[ai][bj][m][0], r1 = X_[sl][bj][1] + acc[ai][bj][m][1]; \
            *(f32x4*)(X1 + o) = r0; *(f32x4*)(X1 + o + 4) = r1; *(u32x4*)(X1B + o) = pg8::pack8(r0, r1); } } while (0)
        EPI_PIPE(P4_LOADS, P4_USES);
#undef P4_LOADS
#undef P4_USES
    }
};
struct EpiP8 {
    const float* X2; const float* RS2; const bf16_t* PLE; float* out;
    __device__ __forceinline__ void operator()(const acc_t& acc, const pg8::Unit& u, int, int wr, int wc, int fr, int fq, LAS unsigned char*) const {
        const int colt = u.pn * 256 + wc * 32 + 8 * fq;
        EPI_ROWS_BEGIN const size_t row = (size_t)u.pm * 256 + rl_; const float rs = RS2[row];
#pragma unroll
            for (int bj = 0; bj < 2; ++bj) { const size_t o = row * DM + colt + bj * 128;
                f32x4 p0, p1; unpack8(*(const u32x4*)(PLE + o), p0, p1);
                f32x4 r0 = *(const f32x4*)(X2 + o), r1 = *(const f32x4*)(X2 + o + 4);
#pragma unroll
                for (int i = 0; i < 4; ++i) { r0[i] += fast_sigmoid(acc[ai][bj][m][0][i] * rs) * p0[i]; r1[i] += fast_sigmoid(acc[ai][bj][m][1][i] * rs) * p1[i]; }
                *(f32x4*)(out + o) = r0; *(f32x4*)(out + o + 4) = r1; }
        EPI_ROWS_END
    }
};


constexpr int CW_PANEL = 8192;
struct EpiP8Fused {
    const float* X2; const float* RS2; const bf16_t* PLE; float* out; const float* g_final; float* SS  ; unsigned* pcnt; unsigned* tmo;
    __device__ __forceinline__ void operator()(const acc_t& acc_in, const pg8::Unit& u, int, int wr, int wc, int fr, int fq, LAS unsigned char* lds) const {
        acc_t& acc = const_cast<acc_t&>(acc_in);
        int tid = threadIdx.x; asm volatile("" : "+v"(tid)); const int lane = tid & 63, wid = __builtin_amdgcn_readfirstlane(tid >> 6);
        LAS float* P = (LAS float*)(lds + 131072); LAS float* S = P + 1024; LAS unsigned* flag = (LAS unsigned*)(S + 256);
        const int colt = u.pn * 256 + wc * 32 + 8 * fq;
        u32x4 PL_[2][2]; f32x4 X_[2][2][2]; float RS_[2];
#define P8_LOADS(it, sl) do { const size_t row = (size_t)u.pm * 256 + EPI_RL(it); RS_[sl] = RS2[row]; _Pragma("unroll") for (int bj = 0; bj < 2; ++bj) { const size_t o = row * DM + colt + bj * 128; \
            PL_[sl][bj] = *(const u32x4*)(PLE + o); X_[sl][bj][0] = *(const f32x4*)(X2 + o); X_[sl][bj][1] = *(const f32x4*)(X2 + o + 4); } } while (0)
#define P8_USES(it, sl) do { const int rl_ = EPI_RL(it); const int ai = (it) >> 2, m = (it) & 3; const float rs = RS_[sl]; float sq = 0.f; _Pragma("unroll") for (int bj = 0; bj < 2; ++bj) { \
            f32x4 p0, p1; unpack8(PL_[sl][bj], p0, p1); f32x4 r0 = X_[sl][bj][0], r1 = X_[sl][bj][1]; \
            _Pragma("unroll") for (int i = 0; i < 4; ++i) { r0[i] += fast_sigmoid(acc[ai][bj][m][0][i] * rs) * p0[i]; r1[i] += fast_sigmoid(acc[ai][bj][m][1][i] * rs) * p1[i]; sq += r0[i] * r0[i] + r1[i] * r1[i]; } \
            acc[ai][bj][m][0] = r0; acc[ai][bj][m][1] = r1; } \
            sq += __shfl_xor(sq, 16); sq += __shfl_xor(sq, 32); \
            if (fq == 0) P[rl_ * 4 + wc] = sq; } while (0)
        EPI_PIPE(P8_LOADS, P8_USES);
#undef P8_LOADS
#undef P8_USES
        asm volatile("s_waitcnt lgkmcnt(0)" ::: "memory"); __builtin_amdgcn_s_barrier(); asm volatile("" ::: "memory");
        if (tid < 256) { const f32x4 q = *(LAS const f32x4*)(P + tid * 4);
            __hip_atomic_store(SS + ((size_t)u.pm * 256 + tid) * 8 + u.pn, (q.x + q.y) + (q.z + q.w), __ATOMIC_RELAXED, __HIP_MEMORY_SCOPE_AGENT); }
        asm volatile("s_waitcnt vmcnt(0)" ::: "memory");
        if (wid < 4 && lane == 0) __hip_atomic_fetch_add(pcnt + 64 * u.pm, 1u, __ATOMIC_RELAXED, __HIP_MEMORY_SCOPE_AGENT);
        if (wid == 0) { unsigned sp = 0;
            while ((unsigned)__builtin_amdgcn_readfirstlane(__hip_atomic_load(pcnt + 64 * u.pm, __ATOMIC_RELAXED, __HIP_MEMORY_SCOPE_AGENT)) < 32u) {
                __builtin_amdgcn_s_sleep(2); if (++sp > (1u << 22)) { if (lane == 0) __hip_atomic_store(tmo, 1u, __ATOMIC_RELAXED, __HIP_MEMORY_SCOPE_AGENT); break; } }
            __builtin_amdgcn_fence(__ATOMIC_ACQUIRE, "agent"); }
        asm volatile("s_waitcnt vmcnt(0) lgkmcnt(0)" ::: "memory"); __builtin_amdgcn_s_barrier(); asm volatile("" ::: "memory");
        if (tid < 256) { const float* sl = SS + ((size_t)u.pm * 256 + tid) * 8; float t = 0.f;
#pragma unroll
            for (int k = 0; k < 8; ++k) t += __hip_atomic_load(sl + k, __ATOMIC_RELAXED, __HIP_MEMORY_SCOPE_AGENT);
            S[tid] = 1.0f / sqrtf(t * (1.0f / DM) + EPS); }
        asm volatile("s_waitcnt lgkmcnt(0)" ::: "memory"); __builtin_amdgcn_s_barrier(); asm volatile("" ::: "memory");
        f32x4 gv[2][2];
#pragma unroll
        for (int bj = 0; bj < 2; ++bj) { gv[bj][0] = *(const f32x4*)(g_final + colt + bj * 128); gv[bj][1] = *(const f32x4*)(g_final + colt + bj * 128 + 4); }
        EPI_ROWS_BEGIN const size_t row = (size_t)u.pm * 256 + rl_; const float rstd = S[rl_];
#pragma unroll
            for (int bj = 0; bj < 2; ++bj) { const size_t o = row * DM + colt + bj * 128;
                *(f32x4*)(out + o) = acc[ai][bj][m][0] * rstd * gv[bj][0]; *(f32x4*)(out + o + 4) = acc[ai][bj][m][1] * rstd * gv[bj][1]; }
        EPI_ROWS_END
    }
};


struct OneUnit {
    int pm, pn;
    __device__ __forceinline__ bool next(int i, pg8::Unit& u) const { if (i != 0) return false; u.pm = pm; u.pn = pn; u.z = 0; return true; }
    __device__ __forceinline__ int tok(int, int) const { return 0; }
};

constexpr int MOE_TAB_OFF = 131072, MOE_TOK_OFF = 131072 + 1024, MOE_MAXU = 6;
template <int NT> struct MoeOrder {
    LAS const int* tab; LAS const int* toks; int L0, Lend, stride, c;
    __device__ __forceinline__ void decode(int L, int& e, int& mt, int& nt_) const {
        const int mtg = L / NT; nt_ = L % NT; int ee = 0;
#pragma unroll 1
        for (int q = 1; q < NEXP; ++q) if (tab[q] <= mtg) ee = q;
        e = ee; mt = mtg - tab[ee];
    }
    __device__ __forceinline__ int unit(int i) const { const int L = L0 + c + i * stride; return (c < 0 || L >= Lend) ? -1 : L; }
    __device__ __forceinline__ bool next(int i, pg8::Unit& u) const {
        const int L = unit(i); if (L < 0) return false;
        int e, mt, nt_; decode(L, e, mt, nt_);
        u.pm = L / NT; u.pn = e * NT + nt_; u.z = 0; return true;
    }
    __device__ __forceinline__ int tok(int ui, int r) const { return toks[ui * 256 + r]; }
};
struct EpiGU {
    bf16_t* HID; const float* RS1; LAS const int* toks;
    __device__ __forceinline__ void operator()(const acc_t& acc, const pg8::Unit& u, int ui, int wr, int wc, int fr, int fq, LAS unsigned char*) const {
        const int hc = (u.pn & 3) * 128 + wc * 32 + 8 * fq;
        float rs8[8];
#pragma unroll
        for (int it = 0; it < 8; ++it) rs8[it] = RS1[toks[ui * 256 + EPI_RL(it)]];
        EPI_ROWS_BEGIN const float rs = rs8[ai * 4 + m];
            f32x4 h0, h1;
#pragma unroll
            for (int i = 0; i < 4; ++i) { const float g0 = acc[ai][0][m][0][i] * rs, u0 = acc[ai][1][m][0][i] * rs, g1 = acc[ai][0][m][1][i] * rs, u1 = acc[ai][1][m][1][i] * rs;
                h0[i] = g0 * fast_sigmoid(g0) * u0; h1[i] = g1 * fast_sigmoid(g1) * u1; }
            *(u32x4*)(HID + ((size_t)u.pm * 256 + rl_) * DEXP + hc) = pg8::pack8(h0, h1);
        EPI_ROWS_END
    }
};
struct EpiDN {
    bf16_t* YB; const float* GW; const int* LIST; LAS const int* tab;
    __device__ __forceinline__ void operator()(const acc_t& acc, const pg8::Unit& u, int, int wr, int wc, int fr, int fq, LAS unsigned char*) const {
        const int e = u.pn >> 3, mt = u.pm - tab[e], cnt = tab[64 + e];
        const int colt = (u.pn & 7) * 256 + wc * 32 + 8 * fq;
        int as8[8]; float gw8[8];
#pragma unroll
        for (int it = 0; it < 8; ++it) { int r = mt * 256 + EPI_RL(it); r = r < cnt ? r : cnt - 1; as8[it] = LIST[(size_t)e * T + r]; }
#pragma unroll
        for (int it = 0; it < 8; ++it) gw8[it] = GW[as8[it]];
        EPI_ROWS_BEGIN const int r = mt * 256 + rl_;
            if (r < cnt) { const int as = as8[ai * 4 + m]; const float gw = gw8[ai * 4 + m];
#pragma unroll
                for (int bj = 0; bj < 2; ++bj) *(u32x4*)(YB + (size_t)as * DM + colt + bj * 128) = pg8::pack8(acc[ai][bj][m][0] * gw, acc[ai][bj][m][1] * gw); }
        EPI_ROWS_END
    }
};


namespace att {
typedef short bf16x8 __attribute__((ext_vector_type(8)));
typedef short s16x4 __attribute__((ext_vector_type(4)));
typedef float f32x16 __attribute__((ext_vector_type(16)));
constexpr int QBLK = 32, KVBLK = 64, QB = 256, D = 128;
constexpr int SHM_V = KVBLK * D * 2, SHM_K = KVBLK * D * 2;
constexpr int NBUF = 2, OFF_V = 0, OFF_K = NBUF * SHM_V, OFF_WS = NBUF * (SHM_V + SHM_K), OFF_BIAS = OFF_WS + 8 * 64 * 4, OFF_FLAG = OFF_BIAS + NBUF * 64 * 4, ATT_LDS = OFF_FLAG + 16;
constexpr float SB_DONE = 150.f;
constexpr float SCALE = 0.08838834764831845f, C2 = 1.4426950408889634f * SCALE, THR = 8.f;
#define KSWZ(row, colB) ((row) * 256 + ((colB) ^ (((row) & 7) << 4)))
#define SBAR() __builtin_amdgcn_sched_barrier(0)
__device__ __forceinline__ int v_st(int k, int c) { const int kk = (k & ~0xC) | ((k & 4) << 1) | ((k & 8) >> 1); return ((kk >> 3) * 4 + (c >> 5)) * 512 + ((kk & 7) * 32 + (c & 31)) * 2; }
__device__ __forceinline__ int v_rd_base(int lane) { return ((lane & 3) << 3) | (((lane >> 2) & 3) << 6) | (((lane >> 4) & 1) << 5) | (((lane >> 5) & 1) << 8); }
constexpr int v_rd_off(int d0, int ks, int half) { return d0 * 512 + ks * 4096 + half * 2048; }
__device__ __forceinline__ int crow(int r, int hi) { return (r & 3) + 8 * (r >> 2) + 4 * hi; }
__device__ __forceinline__ unsigned cvtpk(float lo, float hi) { return pg8::cvt_pk_bf16(lo, hi); }
__device__ __forceinline__ bf16x8 ld8(const bf16_t* p) { return *reinterpret_cast<const bf16x8*>(p); }

template <int KB, bool PF = false>
__device__ __forceinline__ void qkt(f32x16& p0, f32x16& p1, LAS const char* K_lds, int r32, int hi, const bf16x8* qr) {
    p0 = f32x16{}; p1 = f32x16{};
    LAS const char* kb[4];
#pragma unroll
    for (int dd = 0; dd < 4; ++dd) kb[dd] = K_lds + KB * SHM_K + KSWZ(r32, (dd * 16 + hi * 8) * 2);
    if constexpr (PF) {
        bf16x8 fa[4][2], fb[4][2];
#pragma unroll
        for (int d0 = 0; d0 < 4; ++d0) { LAS const char* a = kb[d0 & 3]; fa[d0][0] = *reinterpret_cast<LAS const bf16x8*>(a); fa[d0][1] = *reinterpret_cast<LAS const bf16x8*>(a + 32 * 256); }
#pragma unroll
        for (int d0 = 0; d0 < 4; ++d0) { LAS const char* a = kb[d0 & 3] + 128; fb[d0][0] = *reinterpret_cast<LAS const bf16x8*>(a); fb[d0][1] = *reinterpret_cast<LAS const bf16x8*>(a + 32 * 256); }
#pragma unroll
        for (int d0 = 0; d0 < 4; ++d0) { p0 = __builtin_amdgcn_mfma_f32_32x32x16_bf16(fa[d0][0], qr[d0], p0, 0, 0, 0); p1 = __builtin_amdgcn_mfma_f32_32x32x16_bf16(fa[d0][1], qr[d0], p1, 0, 0, 0); }
#pragma unroll
        for (int d0 = 0; d0 < 4; ++d0) { p0 = __builtin_amdgcn_mfma_f32_32x32x16_bf16(fb[d0][0], qr[4 + d0], p0, 0, 0, 0); p1 = __builtin_amdgcn_mfma_f32_32x32x16_bf16(fb[d0][1], qr[4 + d0], p1, 0, 0, 0); }
    } else {
#pragma unroll
    for (int d0 = 0; d0 < 8; ++d0) { LAS const char* a = kb[d0 & 3] + (d0 >> 2) * 128;
        const bf16x8 b0 = *reinterpret_cast<LAS const bf16x8*>(a);
        const bf16x8 b1 = *reinterpret_cast<LAS const bf16x8*>(a + 32 * 256);
        p0 = __builtin_amdgcn_mfma_f32_32x32x16_bf16(b0, qr[d0], p0, 0, 0, 0);
        p1 = __builtin_amdgcn_mfma_f32_32x32x16_bf16(b1, qr[d0], p1, 0, 0, 0); }
    }
}
template <int VB>
__device__ __forceinline__ void pv_tile(f32x16* o, int vb0, bf16x8 pa0, bf16x8 pa1, bf16x8 pa2, bf16x8 pa3) {
#define TRRD(dst, off) asm volatile("ds_read_b64_tr_b16 %0, %1 offset:%2" : "=&v"(dst) : "v"(vb0), "i"(off) : "memory")
#define PV_D0(d0) do { s16x4 l0, l1, l2, l3, h0, h1, h2, h3; constexpr int b_ = OFF_V + VB * SHM_V + v_rd_off(d0, 0, 0); \
        TRRD(l0, b_); TRRD(h0, b_ + 2048); TRRD(l1, b_ + 4096); TRRD(h1, b_ + 6144); TRRD(l2, b_ + 8192); TRRD(h2, b_ + 10240); TRRD(l3, b_ + 12288); TRRD(h3, b_ + 14336); \
        asm volatile("s_waitcnt lgkmcnt(0)" ::: "memory"); SBAR(); \
        o[d0] = __builtin_amdgcn_mfma_f32_32x32x16_bf16(pa0, (bf16x8){l0[0], l0[1], l0[2], l0[3], h0[0], h0[1], h0[2], h0[3]}, o[d0], 0, 0, 0); \
        o[d0] = __builtin_amdgcn_mfma_f32_32x32x16_bf16(pa1, (bf16x8){l1[0], l1[1], l1[2], l1[3], h1[0], h1[1], h1[2], h1[3]}, o[d0], 0, 0, 0); \
        o[d0] = __builtin_amdgcn_mfma_f32_32x32x16_bf16(pa2, (bf16x8){l2[0], l2[1], l2[2], l2[3], h2[0], h2[1], h2[2], h2[3]}, o[d0], 0, 0, 0); \
        o[d0] = __builtin_amdgcn_mfma_f32_32x32x16_bf16(pa3, (bf16x8){l3[0], l3[1], l3[2], l3[3], h3[0], h3[1], h3[2], h3[3]}, o[d0], 0, 0, 0); } while (0)
    PV_D0(0); PV_D0(1); PV_D0(2); PV_D0(3);
#undef PV_D0
#undef TRRD
}
#define PK4(P, B_, OUT) do { const unsigned a0 = cvtpk(P[B_+0], P[B_+1]), a1 = cvtpk(P[B_+2], P[B_+3]), b0 = cvtpk(P[B_+4], P[B_+5]), b1 = cvtpk(P[B_+6], P[B_+7]); \
        auto r0 = __builtin_amdgcn_permlane32_swap(a0, b0, false, false); auto r1 = __builtin_amdgcn_permlane32_swap(a1, b1, false, false); \
        u32x4 w = {r0[0], r1[0], r0[1], r1[1]}; OUT = *reinterpret_cast<bf16x8*>(&w); } while (0)
__device__ __forceinline__ float xor1(float v) { return __builtin_bit_cast(float, __builtin_amdgcn_mov_dpp(__builtin_bit_cast(int, v), 0xB1, 0xF, 0xF, true)); }
__device__ __forceinline__ float xor2(float v) { return __builtin_bit_cast(float, __builtin_amdgcn_mov_dpp(__builtin_bit_cast(int, v), 0x4E, 0xF, 0xF, true)); }
template <int O> __device__ __forceinline__ float xorsw(float v) { return __builtin_bit_cast(float, __builtin_amdgcn_ds_swizzle(__builtin_bit_cast(int, v), 0x1F | (O << 10))); }
__device__ __forceinline__ float half_swap_add(float v) { auto rr = __builtin_amdgcn_permlane32_swap(__float_as_uint(v), __float_as_uint(v), false, false); return __uint_as_float(rr[0]) + __uint_as_float(rr[1]); }
__device__ __forceinline__ float half_swap_max(float v) { auto rr = __builtin_amdgcn_permlane32_swap(__float_as_uint(v), __float_as_uint(v), false, false); return fmaxf(__uint_as_float(rr[0]), __uint_as_float(rr[1])); }

template <int BR>
__device__ __forceinline__ void attn_unit(const bf16_t* Q, const bf16_t* K, const bf16_t* V, bf16_t* O, const float* NB, int P0, int t_begin, int t_end, float* LSE  , LAS char* lds) {
    constexpr int LDK = NQKV, LDO = WA;
    int tid = threadIdx.x; asm volatile("" : "+v"(tid));
    const int wid = __builtin_amdgcn_readfirstlane(tid >> 6), lane = tid & 63, r32 = lane & 31, hi = lane >> 5;
    const int NTF = P0 / KVBLK + 4;
    const int NT = t_end - t_begin;
    const int qlo = P0 + wid * QBLK, qpos = qlo + r32 - (BR ? 1 : 0);
    LAS char* V_lds = lds + OFF_V; LAS char* K_lds = lds + OFF_K;
    LAS float* wsf = (LAS float*)(lds + OFF_WS) + wid * 64; LAS float* BIAS = (LAS float*)(lds + OFF_BIAS); LAS unsigned* FLAG = (LAS unsigned*)(lds + OFF_FLAG);
    const int sr = tid >> 4, sc = (tid & 15) * 8, vst0 = v_st(sr, sc), vst1 = v_st(32 + sr, sc), kws = KSWZ(sr, sc * 2);
    const int vb0 = (int)(uintptr_t)(lds) + v_rd_base(lane);
    bf16x8 qr[8];
#pragma unroll
    for (int d0 = 0; d0 < 8; ++d0) qr[d0] = ld8(Q + (size_t)(wid * QBLK + r32) * LDK + d0 * 16 + hi * 8);
    bf16x8 st_v0, st_v1, st_k0, st_k1; f32x4 st_b = {0.f, 0.f, 0.f, 0.f};
#define KBASE(t) (BR ? (NTF - 1 - (t)) * KVBLK : (t_begin + (t)) * KVBLK)
#define SLOAD(t) do { const int k0_ = KBASE(t); st_v0 = ld8(V + (size_t)(k0_ + sr) * LDK + sc); st_v1 = ld8(V + (size_t)(k0_ + 32 + sr) * LDK + sc); \
        st_k0 = ld8(K + (size_t)(k0_ + sr) * LDK + sc); st_k1 = ld8(K + (size_t)(k0_ + 32 + sr) * LDK + sc); \
        if (BR == 0 && tid < 16) st_b = *(const f32x4*)(NB + k0_ + tid * 4); } while (0)
#define SWRITE(bf) do { *(LAS bf16x8*)(K_lds + (bf) * SHM_K + kws) = st_k0; *(LAS bf16x8*)(K_lds + (bf) * SHM_K + kws + 32 * 256) = st_k1; \
        *(LAS bf16x8*)(V_lds + (bf) * SHM_V + vst0) = st_v0; *(LAS bf16x8*)(V_lds + (bf) * SHM_V + vst1) = st_v1; \
        if (BR == 0 && tid < 16) *(LAS f32x4*)(BIAS + (bf) * 64 + tid * 4) = st_b; } while (0)
#define VMW() asm volatile("s_waitcnt vmcnt(0)" ::: "memory")
    f32x16 o[4] = {};
    float m_reg = -1e30f, l_reg = 0.f, carry = 0.f, carry_min = 0.f;
    bf16x8 U0, U1;
    if (BR) { u32x4 w0, w1;
#pragma unroll
        for (int jj = 0; jj < 4; ++jj) { unsigned a = 0, b = 0;
#pragma unroll
            for (int e = 0; e < 2; ++e) { const int j = 2 * jj + e; const int k0 = 8 * (j >> 2) + 4 * hi + (j & 3), k1 = 16 + k0;
                a |= (k0 > r32 ? 0x3F80u : 0u) << (16 * e); b |= (k1 > r32 ? 0x3F80u : 0u) << (16 * e); }
            w0[jj] = a; w1[jj] = b; }
        U0 = *reinterpret_cast<bf16x8*>(&w0); U1 = *reinterpret_cast<bf16x8*>(&w1); }
    if (BR && tid < 3) FLAG[tid] = 0u;
    SLOAD(0); VMW(); SWRITE(0); if (NT > 1) SLOAD(1);
    __syncthreads();
    bool alldone = false;
#define STEP(t, BUF) do { \
        if ((t) + 1 < NT) { VMW(); SWRITE((BUF) ^ 1); } \
        if ((t) + 2 < NT) SLOAD((t) + 2); \
        SBAR(); \
        const int kb_ = KBASE(t); \
        const bool act_ = BR ? (kb_ <= qlo + QBLK - 2 && carry_min < SB_DONE) : (kb_ <= qlo + QBLK - 1);     \
        if (act_) { \
        f32x16 p0, p1; qkt<BUF>(p0, p1, K_lds, r32, hi, qr); \
        bf16x8 pa0, pa1, pa2, pa3; \
        if (BR == 0) { \
            _Pragma("unroll") for (int g = 0; g < 4; ++g) { const f32x4 b0 = *(LAS const f32x4*)(BIAS + (BUF) * 64 + 8 * g + 4 * hi), b1 = *(LAS const f32x4*)(BIAS + (BUF) * 64 + 32 + 8 * g + 4 * hi); \
                _Pragma("unroll") for (int i = 0; i < 4; ++i) { p0[4 * g + i] += b0[i]; p1[4 * g + i] += b1[i]; } } \
            if (kb_ + KVBLK - 1 > qlo) { const float NEG = -__builtin_inff(); \
                _Pragma("unroll") for (int r = 0; r < 16; ++r) { const int key = kb_ + crow(r, hi); if (key > qpos) p0[r] = NEG; if (key + 32 > qpos) p1[r] = NEG; } } \
            float pmax = p0[0]; _Pragma("unroll") for (int r = 1; r < 16; ++r) pmax = fmaxf(pmax, p0[r]); _Pragma("unroll") for (int r = 0; r < 16; ++r) pmax = fmaxf(pmax, p1[r]); \
            pmax = half_swap_max(pmax); \
            float alpha = 1.f; \
            if (!__all((pmax - m_reg) * SCALE <= THR)) { const float mn = fmaxf(m_reg, pmax); alpha = __builtin_amdgcn_exp2f((m_reg - mn) * C2); m_reg = mn; } \
            const float mnL = -m_reg * C2; float ps = 0.f; \
            _Pragma("unroll") for (int r = 0; r < 16; ++r) { p0[r] = __builtin_amdgcn_exp2f(fmaf(p0[r], C2, mnL)); p1[r] = __builtin_amdgcn_exp2f(fmaf(p1[r], C2, mnL)); } \
            _Pragma("unroll") for (int r = 0; r < 16; ++r) ps += p0[r] + p1[r]; \
            ps = half_swap_add(ps); l_reg = l_reg * alpha + ps; \
            if (__any(alpha < 1.f)) { if (hi == 0) wsf[r32] = alpha; asm volatile("s_waitcnt lgkmcnt(0)" ::: "memory"); \
                _Pragma("unroll") for (int r = 0; r < 16; ++r) { const float al = wsf[crow(r, hi)]; o[0][r] *= al; o[1][r] *= al; o[2][r] *= al; o[3][r] *= al; } } \
        } else { \
            const float NEG = -__builtin_inff(); const bool msk = kb_ + KVBLK - 1 > qlo - 1; \
            _Pragma("unroll") for (int r = 0; r < 16; ++r) { const int key = kb_ + crow(r, hi); float z0 = p0[r] * C2, z1 = p1[r] * C2; \
                if (msk) { if (key > qpos) z0 = NEG; if (key + 32 > qpos) z1 = NEG; } p0[r] = z0; p1[r] = z1; } \
            f32x16 s0, s1; float t0 = 0.f, t1 = 0.f; \
            _Pragma("unroll") for (int r = 0; r < 16; ++r) { s0[r] = __builtin_amdgcn_logf(1.f + __builtin_amdgcn_exp2f(p0[r])); s1[r] = __builtin_amdgcn_logf(1.f + __builtin_amdgcn_exp2f(p1[r])); t0 += s0[r]; t1 += s1[r]; } \
            t0 = half_swap_add(t0); t1 = half_swap_add(t1); \
            bf16x8 x00, x01, x10, x11; \
            { u32x4 w = {cvtpk(s0[0], s0[1]), cvtpk(s0[2], s0[3]), cvtpk(s0[4], s0[5]), cvtpk(s0[6], s0[7])}; x00 = *reinterpret_cast<bf16x8*>(&w); } \
            { u32x4 w = {cvtpk(s0[8], s0[9]), cvtpk(s0[10], s0[11]), cvtpk(s0[12], s0[13]), cvtpk(s0[14], s0[15])}; x01 = *reinterpret_cast<bf16x8*>(&w); } \
            { u32x4 w = {cvtpk(s1[0], s1[1]), cvtpk(s1[2], s1[3]), cvtpk(s1[4], s1[5]), cvtpk(s1[6], s1[7])}; x10 = *reinterpret_cast<bf16x8*>(&w); } \
            { u32x4 w = {cvtpk(s1[8], s1[9]), cvtpk(s1[10], s1[11]), cvtpk(s1[12], s1[13]), cvtpk(s1[14], s1[15])}; x11 = *reinterpret_cast<bf16x8*>(&w); } \
            const float c0 = carry + t1, c1 = carry; carry += t0 + t1; \
            { f32x16 y0 = {}; y0 = __builtin_amdgcn_mfma_f32_32x32x16_bf16(U0, x00, y0, 0, 0, 0); y0 = __builtin_amdgcn_mfma_f32_32x32x16_bf16(U1, x01, y0, 0, 0, 0); \
              _Pragma("unroll") for (int r = 0; r < 16; ++r) p0[r] = __builtin_amdgcn_exp2f(p0[r] - s0[r] - y0[r] - c0); } \
            SBAR(); \
            { f32x16 y1 = {}; y1 = __builtin_amdgcn_mfma_f32_32x32x16_bf16(U0, x10, y1, 0, 0, 0); y1 = __builtin_amdgcn_mfma_f32_32x32x16_bf16(U1, x11, y1, 0, 0, 0); \
              _Pragma("unroll") for (int r = 0; r < 16; ++r) p1[r] = __builtin_amdgcn_exp2f(p1[r] - s1[r] - y1[r] - c1); } \
            { float cm = carry; cm = fminf(cm, xor1(cm)); cm = fminf(cm, xor2(cm)); cm = fminf(cm, xorsw<4>(cm)); cm = fminf(cm, xorsw<8>(cm)); cm = fminf(cm, xorsw<16>(cm)); carry_min = cm; } \
        } \
        PK4(p0, 0, pa0); PK4(p0, 8, pa1); PK4(p1, 0, pa2); PK4(p1, 8, pa3); \
        SBAR(); pv_tile<BUF>(o, vb0, pa0, pa1, pa2, pa3); } \
        if (BR) { if (lane == 0) { if (carry_min < SB_DONE) __hip_atomic_fetch_add(&FLAG[(t) % 3], 1u, __ATOMIC_RELAXED, __HIP_MEMORY_SCOPE_WORKGROUP); } if (tid == 0) FLAG[((t) + 1) % 3] = 0u; } \
        __syncthreads(); \
        if (BR) { alldone = FLAG[(t) % 3] == 0u; } } while (0)
    if constexpr (BR == 1) {
    int t = 0;
    for (; t + 1 < NT; t += 2) { STEP(t, 0); if (BR && alldone) break; STEP(t + 1, 1); if (BR && alldone) break; }
    if (!(BR && alldone) && t < NT) { STEP(t, 0); }
    } else {
#define ACTF(t) (KBASE(t) <= qlo + QBLK - 1)
#define QKTF(KB, P0, P1, t) qkt<KB, false>(P0, P1, K_lds, r32, hi, qr)
#define PARTIALF(P0, P1, BUF, t, mnX, alX) do { const int kb_ = KBASE(t); \
        _Pragma("unroll") for (int g = 0; g < 4; ++g) { const f32x4 b0 = *(LAS const f32x4*)(BIAS + (BUF) * 64 + 8 * g + 4 * hi), b1 = *(LAS const f32x4*)(BIAS + (BUF) * 64 + 32 + 8 * g + 4 * hi); \
            _Pragma("unroll") for (int i = 0; i < 4; ++i) { P0[4 * g + i] += b0[i]; P1[4 * g + i] += b1[i]; } } \
        if (kb_ + KVBLK - 1 > qlo) { const float NEG = -__builtin_inff(); \
            _Pragma("unroll") for (int r = 0; r < 16; ++r) { const int key = kb_ + crow(r, hi); if (key > qpos) P0[r] = NEG; if (key + 32 > qpos) P1[r] = NEG; } } \
        float pmax = P0[0]; _Pragma("unroll") for (int r = 1; r < 16; ++r) pmax = fmaxf(pmax, P0[r]); _Pragma("unroll") for (int r = 0; r < 16; ++r) pmax = fmaxf(pmax, P1[r]); \
        pmax = half_swap_max(pmax); \
        if (__builtin_expect(__all((pmax - m_reg) * SCALE <= THR), 1)) { alX = 1.f; } \
        else { const float mn_ = fmaxf(m_reg, pmax); alX = __builtin_amdgcn_exp2f((m_reg - mn_) * C2); m_reg = mn_; } \
        const float mnL = -m_reg * C2; \
        _Pragma("unroll") for (int r = 0; r < 16; ++r) { P0[r] = fmaf(P0[r], C2, mnL); P1[r] = fmaf(P1[r], C2, mnL); } \
        _Pragma("unroll") for (int r = 0; r < 16; ++r) P0[r] = __builtin_amdgcn_exp2f(P0[r]); } while (0)
#define FINISHF(P0, P1, alY) do { _Pragma("unroll") for (int r = 0; r < 16; ++r) P1[r] = __builtin_amdgcn_exp2f(P1[r]); \
        float ps = 0.f; _Pragma("unroll") for (int r = 0; r < 16; ++r) ps += P0[r]; _Pragma("unroll") for (int r = 0; r < 16; ++r) ps += P1[r]; \
        ps = half_swap_add(ps); l_reg = l_reg * (alY) + ps; \
        PK4(P0, 0, pa0); PK4(P0, 8, pa1); PK4(P1, 0, pa2); PK4(P1, 8, pa3); } while (0)
#define RESCF(a_) do { if (__any((a_) < 1.f)) { if (hi == 0) wsf[32 + r32] = (a_); asm volatile("s_waitcnt lgkmcnt(0)" ::: "memory"); \
        _Pragma("unroll") for (int d_ = 0; d_ < 4; ++d_) _Pragma("unroll") for (int r = 0; r < 16; ++r) o[d_][r] *= wsf[32 + crow(r, hi)]; } } while (0)
#define PVF(VB, t) pv_tile<VB>(o, vb0, pa0, pa1, pa2, pa3)
    f32x16 pA0, pA1, pB0, pB1; float mnA = 0.f, mnB = 0.f, alA, alB; bf16x8 pa0, pa1, pa2, pa3; (void)mnA; (void)mnB;
    SBAR(); QKTF(0, pA0, pA1, 0);
    PARTIALF(pA0, pA1, 0, 0, mnA, alA);
    if (NT > 1) { VMW(); SWRITE(1); if (NT > 2) SLOAD(2); }
    RESCF(alA);
    __syncthreads();
#define HSF(PX0, PX1, mnX, alX, PY0, PY1, alY, t, KB, VB, SB) do { \
        SBAR(); QKTF(KB, PX0, PX1, t); \
        FINISHF(PY0, PY1, alY); \
        _Pragma("unroll") for (int i_ = 0; i_ < 8; ++i_) { __builtin_amdgcn_sched_group_barrier(0x100, 2, 0); __builtin_amdgcn_sched_group_barrier(0x8, 2, 0); __builtin_amdgcn_sched_group_barrier(0x2, 12, 0); } \
        SBAR(); \
        PVF(VB, (t) - 1); PARTIALF(PX0, PX1, KB, t, mnX, alX); \
        __syncthreads(); \
        if ((t) + 1 < NT) { VMW(); SWRITE(SB); if ((t) + 2 < NT) SLOAD((t) + 2); } \
        RESCF(alX); __syncthreads(); } while (0)
    int t = 1;
    for (; t + 1 < NT; t += 2) {
        HSF(pB0, pB1, mnB, alB, pA0, pA1, alA, t, 1, 0, 0);
        HSF(pA0, pA1, mnA, alA, pB0, pB1, alB, t + 1, 0, 1, 1);
    }
    if (t < NT) { HSF(pB0, pB1, mnB, alB, pA0, pA1, alA, t, 1, 0, 0); SBAR(); FINISHF(pB0, pB1, alB); SBAR(); PVF(1, t); }
    else { SBAR(); FINISHF(pA0, pA1, alA); SBAR(); PVF(0, t - 1); }
    __syncthreads();
#undef HSF
#undef PVF
#undef RESCF
#undef FINISHF
#undef PARTIALF
#undef QKTF
#undef ACTF
    }
    float rli[16];
    { int t3 = threadIdx.x; asm volatile("" : "+v"(t3)); const int r32e = t3 & 31, hie = (t3 >> 5) & 1;
    if (BR == 0 && LSE) { if (hie == 0) LSE[(size_t)(wid * QBLK + r32e) * 8] = m_reg * C2 + __builtin_amdgcn_logf(l_reg); } }
    if (BR == 0) { if (hi == 0) wsf[r32] = l_reg; asm volatile("s_waitcnt lgkmcnt(0)" ::: "memory");
#pragma unroll
        for (int r = 0; r < 16; ++r) rli[r] = __builtin_amdgcn_rcpf(wsf[crow(r, hi)]); }
    else {
#pragma unroll
        for (int r = 0; r < 16; ++r) rli[r] = 1.f; }
    { int t4 = threadIdx.x; asm volatile("" : "+v"(t4)); const int r32e = t4 & 31, hie = (t4 >> 5) & 1;
    bf16_t* Ow = O + (size_t)(wid * QBLK) * LDO;
#pragma unroll
    for (int r = 0; r < 16; ++r) { const int orow = crow(r, hie);
#pragma unroll
        for (int d0 = 0; d0 < 4; ++d0) { const float v = o[d0][r] * rli[r]; const float vn = xor1(v);
            if ((r32e & 1) == 0) *(unsigned*)(Ow + (size_t)orow * LDO + d0 * 32 + r32e) = cvtpk(v, vn); } } }
    __syncthreads();
#undef STEP
#undef KBASE
#undef SLOAD
#undef SWRITE
#undef VMW
}
#undef PK4
}

__device__ __forceinline__ void base_attn_row(const Args& a, int br, int b, int h, int t, LAS float* S, LAS float* qs, int lane) {
    const bf16_t* QKV = (const bf16_t*)(a.ws + WS_QKV);
    const bf16_t* Qp = QKV + (size_t)(b * SEQ + t) * NQKV + br * 3072 + h * HD;
    const bf16_t* Kp = QKV + (size_t)(b * SEQ) * NQKV + br * 3072 + 1024 + h * HD;
    const bf16_t* Vp = QKV + (size_t)(b * SEQ) * NQKV + br * 3072 + 2048 + h * HD;
    const float* CUM = (const float*)(a.ws + WS_CUM) + (size_t)(b * NH + h) * SEQ;
    bf16_t* O = (bf16_t*)(a.ws + (br == 0 ? WS_OA : WS_OB)) + (size_t)(b * SEQ + t) * WA + h * HD;
    { const unsigned w = *(const unsigned*)(Qp + 2 * lane); qs[2 * lane] = bflo(w); qs[2 * lane + 1] = bfhi(w); }
    LDS_WAIT(); asm volatile("" ::: "memory");
    const int n = br == 0 ? t + 1 : t;
    float mx = -1e30f;
    for (int j0 = 0; j0 < n; j0 += 64) {
        const int j = j0 + lane; const int jc = j < n ? j : n - 1;
        const bf16_t* kr = Kp + (size_t)jc * NQKV;
        float d = 0.f;
#pragma unroll 4
        for (int c = 0; c < 16; ++c) {
            const u32x4 w = *(const u32x4*)(kr + 8 * c);
            const f32x4 q0 = *(const LAS f32x4*)(qs + 8 * c), q1 = *(const LAS f32x4*)(qs + 8 * c + 4);
            d += bflo(w.x) * q0.x + bfhi(w.x) * q0.y + bflo(w.y) * q0.z + bfhi(w.y) * q0.w + bflo(w.z) * q1.x + bfhi(w.z) * q1.y + bflo(w.w) * q1.z + bfhi(w.w) * q1.w;
        }
        float s = d * QK_SCALE;
        if (br == 0) s -= CUM[jc];
        if (j < n) { S[j] = s; mx = fmaxf(mx, s); }
    }
    LDS_WAIT(); asm volatile("" ::: "memory");
    float inv = 1.f;
    if (br == 0) {
        mx = wave_max(mx);
        float l = 0.f;
        for (int j = lane; j < n; j += 64) { const float e = expf(S[j] - mx); S[j] = e; l += e; }
        l = wave_sum(l); inv = 1.f / l;
    } else {
        float carry = 0.f;
        const int nch = (n + 63) / 64;
        for (int c = nch - 1; c >= 0; --c) {
            const int j = c * 64 + lane; const bool valid = j < n;
            const float z = valid ? S[j] : 0.f;
            const float L = valid ? logsig(-z) : 0.f;
            float incl = L;
#pragma unroll
            for (int o = 1; o < 64; o <<= 1) { const float tt = __shfl_down(incl, o); if (lane + o < 64) incl += tt; }
            const float after = carry + (incl - L);
            if (valid) S[j] = expf(logsig(z) + after);
            carry += __shfl(incl, 0);
        }
    }
    LDS_WAIT(); asm volatile("" ::: "memory");
    float o0 = 0.f, o1 = 0.f;
    const bf16_t* vp = Vp + 2 * lane;
#pragma unroll 8
    for (int j = 0; j < n; ++j) { const float p = S[j]; const unsigned w = *(const unsigned*)(vp + (size_t)j * NQKV); o0 += p * bflo(w); o1 += p * bfhi(w); }
    *(unsigned*)(O + 2 * lane) = pk2(o0 * inv, o1 * inv);
    LDS_WAIT(); asm volatile("" ::: "memory");
}

__device__ __forceinline__ void p_router(const Args& a, LAS float* ldsf, int bid, int G, int wave, int lane, int tid, float* GW, int* LIST, unsigned* cnt) {
    typedef short bf16x8 __attribute__((ext_vector_type(8)));
    const float* X1 = (const float*)(a.ws + WS_X1); const bf16_t* WRH = (const bf16_t*)(a.ws + WS_WRH); const bf16_t* WRL = (const bf16_t*)(a.ws + WS_WRL);
    float* RS1 = (float*)(a.ws + WS_RS1);
    LAS float* part = ldsf;
    LAS float* ssp = ldsf + 8 * 32 * 48;
    LAS float* lgt = ssp + 8 * 32;
    LAS int* asgE = (LAS int*)(lgt + 32 * 36); LAS float* asgW = (LAS float*)(asgE + 64); LAS int* lcnt = (LAS int*)(asgW + 64); LAS int* lbase = lcnt + 32;
    for (int tb = bid; tb < T / 32; tb += G) {
        const int m0 = tb * 32, fr = lane & 15, fq = lane >> 4;
        f32x4 acc[2][3];
#pragma unroll
        for (int mt = 0; mt < 2; ++mt)
#pragma unroll
            for (int nt = 0; nt < 3; ++nt) acc[mt][nt] = (f32x4){0.f, 0.f, 0.f, 0.f};
        float ss0 = 0.f, ss1 = 0.f;
#pragma unroll 2
        for (int ks = 0; ks < 8; ++ks) {
            const int kk = wave * 256 + ks * 32 + 8 * fq;
            bf16x8 ah[2], al[2], bh[3], bl[3];
#pragma unroll
            for (int mt = 0; mt < 2; ++mt) { const float* xp = X1 + (size_t)(m0 + 16 * mt + fr) * DM + kk; const f32x4 x0 = *(const f32x4*)xp, x1 = *(const f32x4*)(xp + 4);
                const float sq = (x0.x * x0.x + x0.y * x0.y) + (x0.z * x0.z + x0.w * x0.w) + (x1.x * x1.x + x1.y * x1.y) + (x1.z * x1.z + x1.w * x1.w);
                if (mt == 0) ss0 += sq; else ss1 += sq;
                u32x4 hw = pg8::pack8(x0, x1);
                const f32x4 r0 = {x0.x - bflo(hw.x), x0.y - bfhi(hw.x), x0.z - bflo(hw.y), x0.w - bfhi(hw.y)}, r1 = {x1.x - bflo(hw.z), x1.y - bfhi(hw.z), x1.z - bflo(hw.w), x1.w - bfhi(hw.w)};
                u32x4 lw = pg8::pack8(r0, r1);
                ah[mt] = *reinterpret_cast<bf16x8*>(&hw); al[mt] = *reinterpret_cast<bf16x8*>(&lw); }
#pragma unroll
            for (int nt = 0; nt < 3; ++nt) { bh[nt] = *(const bf16x8*)(WRH + (size_t)(16 * nt + fr) * DM + kk); bl[nt] = *(const bf16x8*)(WRL + (size_t)(16 * nt + fr) * DM + kk); }
#pragma unroll
            for (int mt = 0; mt < 2; ++mt)
#pragma unroll
                for (int nt = 0; nt < 3; ++nt) {
                    acc[mt][nt] = __builtin_amdgcn_mfma_f32_16x16x32_bf16(ah[mt], bh[nt], acc[mt][nt], 0, 0, 0);
                    acc[mt][nt] = __builtin_amdgcn_mfma_f32_16x16x32_bf16(ah[mt], bl[nt], acc[mt][nt], 0, 0, 0);
                    acc[mt][nt] = __builtin_amdgcn_mfma_f32_16x16x32_bf16(al[mt], bh[nt], acc[mt][nt], 0, 0, 0); }
        }
#pragma unroll
        for (int mt = 0; mt < 2; ++mt)
#pragma unroll
            for (int nt = 0; nt < 3; ++nt)
#pragma unroll
                for (int r = 0; r < 4; ++r) part[(wave * 32 + 16 * mt + 4 * fq + r) * 48 + 16 * nt + fr] = acc[mt][nt][r];
        ss0 += __shfl_xor(ss0, 16); ss0 += __shfl_xor(ss0, 32); ss1 += __shfl_xor(ss1, 16); ss1 += __shfl_xor(ss1, 32);
        if (fq == 0) { ssp[wave * 32 + fr] = ss0; ssp[wave * 32 + 16 + fr] = ss1; }
        if (tid < 32) lcnt[tid] = 0;
        __syncthreads();
        if (lane < 36) {
#pragma unroll
            for (int t = 0; t < 4; ++t) { const int row = wave * 4 + t; float v = 0.f, q = 0.f;
#pragma unroll
                for (int w = 0; w < 8; ++w) { v += part[(w * 32 + row) * 48 + lane]; q += ssp[w * 32 + row]; }
                const float rstd = 1.0f / sqrtf(q * (1.0f / DM) + EPS);
                lgt[row * 36 + lane] = v * rstd; if (lane == 0) RS1[m0 + row] = rstd; }
        }
        asm volatile("s_waitcnt lgkmcnt(0)" ::: "memory");
        if (lane < 4) {
            const int row = wave * 4 + lane; const LAS float* lg = lgt + row * 36;
            const f32x4 gl = *(const LAS f32x4*)(lg + 32);
            int gs = 0; float gm = gl[0];
#pragma unroll
            for (int i = 1; i < 4; ++i) if (gl[i] > gm) { gm = gl[i]; gs = i; }
            float den = 0.f;
#pragma unroll
            for (int i = 0; i < 4; ++i) den += expf(gl[i] - gm);
            const float pg = 1.f / den;
            const f32x4 e0 = *(const LAS f32x4*)(lg + gs * 8), e1 = *(const LAS f32x4*)(lg + gs * 8 + 4);
            float ev[8] = {e0.x, e0.y, e0.z, e0.w, e1.x, e1.y, e1.z, e1.w};
            int i0 = 0; float v0 = ev[0];
#pragma unroll
            for (int i = 1; i < 8; ++i) if (ev[i] > v0) { v0 = ev[i]; i0 = i; }
            int i1 = -1; float v1 = -3.0e38f;
#pragma unroll
            for (int i = 0; i < 8; ++i) if (i != i0 && ev[i] > v1) { v1 = ev[i]; i1 = i; }
            const float ee = expf(v1 - v0); const float w0 = 1.f / (1.f + ee), w1 = ee / (1.f + ee);
            const int la = 2 * row;
            asgE[la] = gs * 8 + i0; asgE[la + 1] = gs * 8 + i1; asgW[la] = w0 * pg; asgW[la + 1] = w1 * pg;
        }
        __syncthreads();
        if (wave == 0) {
            const int e = asgE[lane];
            const int rank = (int)__hip_atomic_fetch_add((LAS unsigned*)&lcnt[e], 1u, __ATOMIC_RELAXED, __HIP_MEMORY_SCOPE_WORKGROUP);
            asm volatile("s_waitcnt lgkmcnt(0)" ::: "memory");
            if (lane < 32) { const int c = lcnt[lane]; lbase[lane] = c > 0 ? (int)atomicAdd(&cnt[lane], (unsigned)c) : 0; }
            asm volatile("s_waitcnt vmcnt(0) lgkmcnt(0)" ::: "memory");
            const int pos = lbase[e] + rank; const int asg = 2 * (tb * 32) + lane;
            LIST[(size_t)e * T + pos] = asg; GW[asg] = asgW[lane];
        }
        __syncthreads();
    }
}

#define XB_TMO      128
#define XB_XCNT(j)  (256  + 64 * (j))
#define XB_XSUB(j)  (1280 + 64 * (j))
#define XB_XGEN(j)  (2304 + 64 * (j))
#define XB_TOP      3328
#define XB_TOPGEN   3392
#define XCD_BAR_WORDS 3456
#define XB_SPIN_CAP (1u << 22)
__device__ __forceinline__ unsigned xb_ld(unsigned* p)              { return __hip_atomic_load(p, __ATOMIC_RELAXED, __HIP_MEMORY_SCOPE_AGENT); }
__device__ __forceinline__ unsigned xb_add(unsigned* p, unsigned v) { return __hip_atomic_fetch_add(p, v, __ATOMIC_RELAXED, __HIP_MEMORY_SCOPE_AGENT); }
__device__ __forceinline__ unsigned xb_xcc_id() { return (unsigned)__builtin_amdgcn_s_getreg((3 << 11) | 20) & 0xFu; }
#define XB_SPIN(cond, bar) do { unsigned _sp = 0; while (cond) { __builtin_amdgcn_s_sleep(1); \
    if ((++_sp & 255u) == 0u) { if (xb_ld(&(bar)[XB_TMO])) break; if (_sp > XB_SPIN_CAP) { atomicAdd(&(bar)[XB_TMO], 1u); break; } } } } while (0)
struct XcdBarrier { unsigned* bar; unsigned x; volatile LAS unsigned* st; };
__device__ __forceinline__ XcdBarrier xcd_barrier_post(unsigned* bar, volatile LAS unsigned* st) {
    XcdBarrier b; b.bar = bar; b.x = xb_xcc_id(); b.st = st;
    if (threadIdx.x == 0) (void)xb_add(&bar[XB_XCNT(b.x)], 1u);
    return b;
}
__device__ __forceinline__ void xcd_barrier_complete(unsigned* bar, unsigned x, unsigned& nloc, unsigned& nx) {
    const unsigned G = gridDim.x * gridDim.y * gridDim.z;
    unsigned sum, cnt, mine, sp = 0u;
    for (;;) {
        sum = 0u; cnt = 0u; mine = 0u;
#pragma unroll
        for (unsigned j = 0; j < 16; ++j) { const unsigned c = xb_ld(&bar[XB_XCNT(j)]); sum += c; cnt += (c > 0u) ? 1u : 0u; mine = (j == x) ? c : mine; }
        if (sum == G) break;
        __builtin_amdgcn_s_sleep(1);
        if ((++sp & 255u) == 0u) { if (xb_ld(&bar[XB_TMO])) break; if (sp > XB_SPIN_CAP) { atomicAdd(&bar[XB_TMO], 1u); break; } }
    }
    nloc = mine > 0u ? mine : 1u; nx = cnt > 0u ? cnt : 1u;
}
__device__ __forceinline__ void xcd_barrier(unsigned* bar, volatile LAS unsigned* st) {
    asm volatile("s_waitcnt vmcnt(0)" ::: "memory");
    __syncthreads();
    if (threadIdx.x == 0) {
        __builtin_amdgcn_s_waitcnt(0);
        const unsigned x = xb_xcc_id();
        unsigned nloc = st[0], nx = st[1];
        if (nloc == 0u) { xcd_barrier_complete(bar, x, nloc, nx); st[0] = nloc; st[1] = nx; }
        const unsigned old = xb_add(&bar[XB_XSUB(x)], 1u);
        const unsigned gen = old / nloc;
        if (old + 1u == (gen + 1u) * nloc) {
            __builtin_amdgcn_fence(__ATOMIC_RELEASE, "agent");
            asm volatile("s_waitcnt vmcnt(0)" ::: "memory");
            const unsigned og = xb_add(&bar[XB_TOP], 1u);
            const unsigned tg = og / nx;
            if (og + 1u == (tg + 1u) * nx) xb_add(&bar[XB_TOPGEN], 1u);
            else XB_SPIN(xb_ld(&bar[XB_TOPGEN]) == tg, bar);
            __builtin_amdgcn_fence(__ATOMIC_ACQUIRE, "agent");
            xb_add(&bar[XB_XGEN(x)], 1u);
            asm volatile("s_waitcnt vmcnt(0)" ::: "memory");
        } else {
            XB_SPIN(xb_ld(&bar[XB_XGEN(x)]) == gen, bar);
            __builtin_amdgcn_fence(__ATOMIC_ACQUIRE, "agent");
            asm volatile("s_waitcnt vmcnt(0)" ::: "memory");
        }
    }
    __syncthreads();
}

#define GRID_SYNC() do { xcd_barrier(xbar, xst); asm volatile("" ::: "memory"); } while (0)
constexpr int CW_BAR = 4096;
constexpr int XST_OFF = LDS_BYTES - 64;
__global__ void __launch_bounds__(NTHREADS, 2) fwd_megakernel(Args a) {
    extern __shared__ __attribute__((aligned(16))) unsigned char lds_raw[];
    volatile LAS unsigned* xst = (volatile LAS unsigned*)((LAS unsigned char*)lds_raw + XST_OFF);
    unsigned* xbar = (unsigned*)(a.ws + WS_CTL) + CW_BAR;
    if (threadIdx.x < 16) xst[threadIdx.x] = 0u;
    __syncthreads();
    (void)xcd_barrier_post(xbar, xst);
    LAS unsigned char* lds = (LAS unsigned char*)lds_raw;
    LAS float* ldsf = (LAS float*)lds_raw;
#define FRESH_IDS() int tid = threadIdx.x; asm volatile("" : "+v"(tid)); const int lane = tid & 63, wave = __builtin_amdgcn_readfirstlane(tid >> 6); \
    int G = gridDim.x, bid = blockIdx.x; asm volatile("" : "+s"(G), "+s"(bid)); const int gw = bid * NWAVES + wave, NGW = G * NWAVES; \
    unsigned char* ws = a.ws; (void)lane; (void)gw; (void)NGW; (void)ws; (void)wave;

    { FRESH_IDS(); p0_prologue(a, lds, gw, NGW, wave, lane, tid); }
    GRID_SYNC();
    { FRESH_IDS(); p_cumsum(a, ldsf, bid, wave, lane, tid); }
    if (FAST(1)) { FRESH_IDS();
        pg8::Gemm g{{(const bf16_t*)(ws + WS_H), nullptr}, {(const bf16_t*)(ws + WS_WTIN), nullptr}, DM};
        pg8::DenseOrder<1> S; S.init(T, NPROJ, G, bid);
        EpiP1 E{(bf16_t*)(ws + WS_QKV), (bf16_t*)(ws + WS_GATES), (float*)(ws + WS_NSQ)};
        pg8::gemm_phase<EpiP1, pg8::DenseOrder<1>, false>(lds, g, S, E);
    }
    if (FAST(9) && !FAST(2)) { FRESH_IDS();
        pg8::Gemm g2{{(const bf16_t*)(ws + WS_PB), nullptr}, {(const bf16_t*)(ws + WS_WTPP), nullptr}, DPLE};
        pg8::DenseOrder<1> S2; S2.init(T, DM, G, bid);
        EpiStoreBf E2{(bf16_t*)(ws + WS_PLE), DM};
        pg8::gemm_phase<EpiStoreBf, pg8::DenseOrder<1>, false>(lds, g2, S2, E2);
    }
    if (!FAST(1)) { FRESH_IDS();
        const bf16_t* H = (const bf16_t*)(ws + WS_H); const bf16_t* WTIN = (const bf16_t*)(ws + WS_WTIN);
        bf16_t* QKV = (bf16_t*)(ws + WS_QKV); bf16_t* GATES = (bf16_t*)(ws + WS_GATES);
        auto epi = [&](int m, int n, f32x4 c, f32x4) {
            if (n < NQKV) st_bf4(QKV + (size_t)m * NQKV + n, c);
            else { f32x4 s = {sigmoidf(c.x), sigmoidf(c.y), sigmoidf(c.z), sigmoidf(c.w)}; st_bf4(GATES + (size_t)m * 4096 + (n - NQKV), s); }
        };
        constexpr int NMT = T / GBM, NNT = NPROJ / GBN;
        for (int u = bid; u < NMT * NNT; u += G) { const int mt = u / NNT, nt = u % NNT;
            base_gemm_tile<1>(H, H, DM, nullptr, 0, T, WTIN, WTIN, DM, DM, mt * GBM, nt * GBN, ldsf, epi); }
    }
    if (!FAST(9)) { FRESH_IDS();
        constexpr int NMT = T / GBM;
        const bf16_t* PB = (const bf16_t*)(ws + WS_PB); const bf16_t* WTPP = (const bf16_t*)(ws + WS_WTPP); bf16_t* PLE = (bf16_t*)(ws + WS_PLE);
        auto epi2 = [&](int m, int n, f32x4 c, f32x4) { st_bf4(PLE + (size_t)m * DM + n, c); };
        constexpr int NNT2 = DM / GBN;
        for (int u = bid; u < NMT * NNT2; u += G) { const int mt = u / NNT2, nt = u % NNT2;
            base_gemm_tile<1>(PB, PB, DPLE, nullptr, 0, T, WTPP, WTPP, DPLE, DPLE, mt * GBM, nt * GBN, ldsf, epi2); }
    }
    GRID_SYNC();
    if (FAST(2)) { FRESH_IDS();
        constexpr int N_FOX = 24 * 16, N_SB = 16 * 16, N_PLE = 256, N_COMP = N_FOX + N_SB + N_PLE, N_CONV = N_CONV_CHUNKS;
        const bool conv_first = ((bid >> 3) % 3) == 0;
        LAS unsigned* qslot = (LAS unsigned*)(lds + 140 * 1024);
        int mode = conv_first ? 1 : 0, switches = 0;
        for (;;) {
            if (threadIdx.x == 0) qslot[0] = __hip_atomic_fetch_add((unsigned*)(ws + WS_CTL) + CW_QHEAD + (mode ? 32 : 0), 1u, __ATOMIC_RELAXED, __HIP_MEMORY_SCOPE_AGENT);
            __syncthreads();
            const int pos = (int)qslot[0];
            __syncthreads();
            const bool valid = pos < (mode ? N_CONV : N_COMP);
            if (!valid) { mode ^= 1; if (++switches >= 2) break; }
            const int conv = (valid && mode) ? pos : -1, comp = (valid && !mode) ? pos : -1;
            if (!valid) {}
            else
            if (conv >= 0) {
                int t2 = threadIdx.x; asm volatile("" : "+v"(t2)); const int lane2 = t2 & 63, wave2 = __builtin_amdgcn_readfirstlane(t2 >> 6);
                LAS float* scr = (LAS float*)(lds + wave2 * 8704);
                conv_wave(a, conv * CONV_CHUNK + wave2, NWAVES, CONV_CHUNK / NWAVES, scr, lane2);
                __syncthreads();
            } else if (comp < N_FOX) {
                const int bh = comp & 15, e = comp >> 4;
                int qb, part;
                {
                  const int pair = e / 5, w = e % 5;
                  if (e < 20) { if (w < 3) { qb = w < 2 ? 15 - 2 * pair : 7 - pair; part = w < 2 ? w : -1; } else { qb = 14 - 2 * pair; part = w - 3; } }
                  else { qb = 23 - e; part = -1; } }
                const int b = bh >> 3, h = bh & 7, P0 = qb * 256, NTF = P0 / 64 + 4;
                const bf16_t* Qp = (const bf16_t*)(ws + WS_QKV) + (size_t)(b * SEQ) * NQKV + h * HD;
                const float* NBp = (const float*)(ws + WS_NB) + (size_t)(b * NH + h) * SEQ;
                const size_t orow = (size_t)(b * SEQ + P0);
                bf16_t* Op = (bf16_t*)(ws + (part == 0 ? WS_OA2 : WS_OA)) + orow * WA + h * HD;
                float* lse = part < 0 ? nullptr : (float*)(ws + (part == 0 ? WS_LSE2 : WS_LSE1)) + orow * 8 + h;
                int t0 = part == 1 ? NTF / 2 : 0; const int t1 = part == 0 ? NTF / 2 : NTF;
                {
                  int t5 = threadIdx.x; asm volatile("" : "+v"(t5));
                  const float* NK = (const float*)(ws + WS_NSQ) + (size_t)((8 + h) * 4) * T + (size_t)b * SEQ; const float* NQ = (const float*)(ws + WS_NSQ) + (size_t)(h * 4) * T + (size_t)b * SEQ;
                  float kq = 0.f, qq = 0.f;
#pragma unroll 1
                  for (int i = t5; i < P0 + 256; i += NTHREADS) kq = fmaxf(kq, (NK[i] + NK[T + i]) + (NK[2 * T + i] + NK[3 * T + i]));
                  if (t5 < 256) { const int i = P0 + t5; qq = (NQ[i] + NQ[T + i]) + (NQ[2 * T + i] + NQ[3 * T + i]); }
                  kq = fmaxf(kq, att::xor1(kq)); kq = fmaxf(kq, att::xor2(kq)); kq = fmaxf(kq, att::xorsw<4>(kq)); kq = fmaxf(kq, att::xorsw<8>(kq)); kq = fmaxf(kq, att::xorsw<16>(kq)); kq = att::half_swap_max(kq);
                  qq = fmaxf(qq, att::xor1(qq)); qq = fmaxf(qq, att::xor2(qq)); qq = fmaxf(qq, att::xorsw<4>(qq)); qq = fmaxf(qq, att::xorsw<8>(qq)); qq = fmaxf(qq, att::xorsw<16>(qq)); qq = att::half_swap_max(qq);
                  LAS float* red = (LAS float*)(lds + 141 * 1024);
                  if ((t5 & 63) == 0) { red[t5 >> 6] = kq; red[8 + (t5 >> 6)] = qq; }
                  __syncthreads();
                  float k2 = red[0], q2 = red[8];
#pragma unroll
                  for (int i = 1; i < 8; ++i) { k2 = fmaxf(k2, red[i]); q2 = fmaxf(q2, red[8 + i]); }
                  const float thr = NBp[P0] - 2.02f * __builtin_sqrtf(k2 * q2) - 1250.f;
                  const int j = t5 & 63; const bool keep = j < NTF && NBp[64 * j + 63] >= thr;
                  const unsigned long long bal = __ballot(keep);
                  const int tf = bal ? (int)__builtin_ctzll(bal) : 0;
                  t0 = max(t0, min(tf, t1 - 1));
                  __syncthreads(); }
                att::attn_unit<0>(Qp + (size_t)P0 * NQKV, Qp + 1024, Qp + 2048, Op, NBp, P0, t0, t1, lse, (LAS char*)lds);
            } else if (comp >= N_FOX + N_SB) {
                const int v = comp - N_FOX - N_SB;
                pg8::Gemm g2{{(const bf16_t*)(ws + WS_PB), nullptr}, {(const bf16_t*)(ws + WS_WTPP), nullptr}, DPLE};
                OneUnit S2{v >> 3, v & 7}; EpiStoreBf E2{(bf16_t*)(ws + WS_PLE), DM};
                pg8::gemm_phase<EpiStoreBf, OneUnit, false>(lds, g2, S2, E2);
            } else {
                const int u = comp - N_FOX, bh = u & 15, qb = 15 - (u >> 4);
                const int b = bh >> 3, h = bh & 7, P0 = qb * 256;
                const bf16_t* Qp = (const bf16_t*)(ws + WS_QKV) + (size_t)(b * SEQ) * NQKV + 3072 + h * HD;
                bf16_t* Op = (bf16_t*)(ws + WS_OB) + (size_t)(b * SEQ + P0) * WA + h * HD;
                att::attn_unit<1>(Qp + (size_t)P0 * NQKV, Qp + 1024, Qp + 2048, Op, nullptr, P0, 0, P0 / 64 + 4, nullptr, (LAS char*)lds);
            }
        }
        GRID_SYNC();
    }
    if (FAST(2)) { FRESH_IDS();
        { const bf16_t* O2 = (const bf16_t*)(ws + WS_OA2); bf16_t* O1 = (bf16_t*)(ws + WS_OA); const float* L1 = (const float*)(ws + WS_LSE1); const float* L2 = (const float*)(ws + WS_LSE2);
          for (int task = gw; task < NBATCH * 2048 * NH; task += NGW) { const int h = task & 7, rr = task >> 3; const int b = rr >> 11, sq = 2048 + (rr & 2047); const size_t row = (size_t)b * SEQ + sq;
              const float l1 = L1[row * 8 + h], l2 = L2[row * 8 + h], mx = fmaxf(l1, l2); const float e1 = __builtin_amdgcn_exp2f(l1 - mx), e2 = __builtin_amdgcn_exp2f(l2 - mx), inv = 1.f / (e1 + e2);
              const unsigned w1 = *(const unsigned*)(O1 + row * WA + h * HD + 2 * lane), w2 = *(const unsigned*)(O2 + row * WA + h * HD + 2 * lane);
              *(unsigned*)(O1 + row * WA + h * HD + 2 * lane) = pk2((bflo(w1) * e1 + bflo(w2) * e2) * inv, (bfhi(w1) * e1 + bfhi(w2) * e2) * inv); } }
    }
    if (!FAST(2) && PH(2)) { FRESH_IDS();
        LAS float* S = ldsf + wave * 4096; LAS float* qs = ldsf + 8 * 4096 + wave * 128;
        const int ntask = 2 * NBATCH * NH * SEQ;
        for (int task = gw; task < ntask; task += NGW) {
            const int c = task & 31, t = task >> 5; const int br = c >> 4, b = (c >> 3) & 1, h = c & 7;
            base_attn_row(a, br, b, h, t, S, qs, lane);
        }
    }
    GRID_SYNC();
    if (FAST(3)) { FRESH_IDS();
        pg8::Gemm g{{(const bf16_t*)(ws + WS_OA), (const bf16_t*)(ws + WS_OB)}, {(const bf16_t*)(ws + WS_WTBF), (const bf16_t*)(ws + WS_WTBS)}, WA};
        pg8::DenseOrder<2> S; S.init(T, DM, G, bid);
        EpiP3 E{(const bf16_t*)(ws + WS_GATES), (bf16_t*)(ws + WS_MIXED)};
        pg8::gemm_phase<EpiP3, pg8::DenseOrder<2>, false>(lds, g, S, E);
    }
    else { FRESH_IDS();
        const bf16_t* OA = (const bf16_t*)(ws + WS_OA); const bf16_t* OB = (const bf16_t*)(ws + WS_OB);
        const bf16_t* WTBF = (const bf16_t*)(ws + WS_WTBF); const bf16_t* WTBS = (const bf16_t*)(ws + WS_WTBS);
        const bf16_t* GATES = (const bf16_t*)(ws + WS_GATES); bf16_t* MIXED = (bf16_t*)(ws + WS_MIXED);
        auto epi = [&](int m, int n, f32x4 ca, f32x4 cb) {
            const f32x4 ga = ld_bf4(GATES + (size_t)m * 4096 + n), gb = ld_bf4(GATES + (size_t)m * 4096 + 2048 + n);
            st_bf4(MIXED + (size_t)m * DM + n, ga * ca + gb * cb);
        };
        constexpr int NMT = T / GBM, NNT = DM / GBN;
        for (int u = bid; u < NMT * NNT; u += G) { const int mt = u / NNT, nt = u % NNT;
            base_gemm_tile<2>(OA, OB, WA, nullptr, 0, T, WTBF, WTBS, WA, WA, mt * GBM, nt * GBN, ldsf, epi); }
    }
    GRID_SYNC();
    if (FAST(4)) { FRESH_IDS();
        pg8::Gemm g{{(const bf16_t*)(ws + WS_MIXED), nullptr}, {(const bf16_t*)(ws + WS_WTMIX), nullptr}, DM};
        pg8::DenseOrder<1> S; S.init(T, DM, G, bid);
        EpiP4 E{a.in[0], (float*)(ws + WS_X1), (bf16_t*)(ws + WS_X1B)};
        pg8::gemm_phase<EpiP4, pg8::DenseOrder<1>, false>(lds, g, S, E);
    }
    else { FRESH_IDS();
        const bf16_t* MIXED = (const bf16_t*)(ws + WS_MIXED); const bf16_t* WTMIX = (const bf16_t*)(ws + WS_WTMIX);
        const float* x = a.in[0]; float* X1 = (float*)(ws + WS_X1); bf16_t* X1B = (bf16_t*)(ws + WS_X1B);
        auto epi = [&](int m, int n, f32x4 c, f32x4) {
            const f32x4 r = *(const f32x4*)(x + (size_t)m * DM + n) + c;
            *(f32x4*)(X1 + (size_t)m * DM + n) = r; st_bf4(X1B + (size_t)m * DM + n, r);
        };
        constexpr int NMT = T / GBM, NNT = DM / GBN;
        for (int u = bid; u < NMT * NNT; u += G) { const int mt = u / NNT, nt = u % NNT;
            base_gemm_tile<1>(MIXED, MIXED, DM, nullptr, 0, T, WTMIX, WTMIX, DM, DM, mt * GBM, nt * GBN, ldsf, epi); }
    }
    GRID_SYNC();
    { FRESH_IDS(); p_router(a, ldsf, bid, G, wave, lane, tid, (float*)(ws + WS_GW), (int*)(ws + WS_LIST), (unsigned*)(ws + WS_CTL) + CW_CNT); }
    GRID_SYNC();
    if (FAST(6)) { FRESH_IDS();
        const unsigned* cnt = (const unsigned*)(ws + WS_CTL) + CW_CNT;
        LAS int* tab = (LAS int*)(lds + MOE_TAB_OFF); LAS int* toks = (LAS int*)(lds + MOE_TOK_OFF);
        const int* LIST = (const int*)(ws + WS_LIST);
        if (tid == 0) { int mp = 0; for (int e = 0; e < NEXP; ++e) { const int c = (int)__hip_atomic_load(cnt + e, __ATOMIC_RELAXED, __HIP_MEMORY_SCOPE_AGENT);
                tab[e] = mp; tab[64 + e] = c; mp += (c + 255) / 256; } tab[NEXP] = mp; }
        __syncthreads();
        const int nmt = tab[NEXP];
        const int m1 = nmt < 64 ? nmt : 64, n2 = (nmt - m1) * 4;
        pg8::Gemm gGU{{(const bf16_t*)(ws + WS_X1B), nullptr}, {(const bf16_t*)(ws + WS_WTGU), nullptr}, DM};
        pg8::Gemm gDN{{(const bf16_t*)(ws + WS_HID), nullptr}, {(const bf16_t*)(ws + WS_WTDN), nullptr}, DEXP};
        EpiGU EGU{(bf16_t*)(ws + WS_HID), (const float*)(ws + WS_RS1), toks};
        EpiDN EDN{(bf16_t*)(ws + WS_YB), (const float*)(ws + WS_GW), LIST, tab};
#define MOE_FILL_TOKS(S) do { for (int i = 0; i < MOE_MAXU; ++i) { const int L = (S).unit(i); if (L < 0) break; int e, mt, nt_; (S).decode(L, e, mt, nt_); \
            if (tid < 256) { int r = mt * 256 + tid; const int c = tab[64 + e]; if (r > c - 1) r = c - 1; toks[i * 256 + tid] = LIST[(size_t)e * T + r] >> 1; } } __syncthreads(); } while (0)
        {
            MoeOrder<4> S{tab, toks, 0, m1 * 4, G, bid};
            MOE_FILL_TOKS(S);
            pg8::gemm_phase<EpiGU, MoeOrder<4>, true>(lds, gGU, S, EGU);
        }
        GRID_SYNC();
        {
            if (bid < n2) { MoeOrder<4> S{tab, toks, m1 * 4, nmt * 4, G, bid}; MOE_FILL_TOKS(S); pg8::gemm_phase<EpiGU, MoeOrder<4>, true>(lds, gGU, S, EGU); }
            else { MoeOrder<8> S{tab, toks, 0, m1 * 8, G - n2, bid - n2}; pg8::gemm_phase<EpiDN, MoeOrder<8>, false>(lds, gDN, S, EDN); }
        }
        GRID_SYNC();
        {
            MoeOrder<8> S{tab, toks, m1 * 8, nmt * 8, G, bid};
            pg8::gemm_phase<EpiDN, MoeOrder<8>, false>(lds, gDN, S, EDN);
        }
#undef MOE_FILL_TOKS
    }
    else { FRESH_IDS();
        const unsigned* cnt = (const unsigned*)(ws + WS_CTL) + CW_CNT;
        LAS int* tab = (LAS int*)(lds + 140 * 1024);
        if (tid == 0) { int mp = 0, off = 0; for (int e = 0; e < NEXP; ++e) { const int c = (int)__hip_atomic_load(cnt + e, __ATOMIC_RELAXED, __HIP_MEMORY_SCOPE_AGENT);
                tab[e] = mp; tab[64 + e] = off; mp += (c + GBM - 1) / GBM; off += ((c + 255) / 256) * 256; } tab[NEXP] = mp; tab[64 + NEXP] = off; }
        __syncthreads();
        const int nmt = tab[NEXP];
        const bf16_t* X1B = (const bf16_t*)(ws + WS_X1B); const bf16_t* WTGU = (const bf16_t*)(ws + WS_WTGU); const bf16_t* WTDN = (const bf16_t*)(ws + WS_WTDN);
        bf16_t* HID = (bf16_t*)(ws + WS_HID); bf16_t* YB = (bf16_t*)(ws + WS_YB);
        const int* LIST = (const int*)(ws + WS_LIST); const float* RS1 = (const float*)(ws + WS_RS1); const float* GW = (const float*)(ws + WS_GW);
        constexpr int NNT_H = DEXP / GBN;
        for (int u = bid; u < nmt * NNT_H; u += G) {
            const int mtg = u / NNT_H, nt = u % NNT_H;
            int e = 0;
            for (int q = 1; q < NEXP; ++q) if (tab[q] <= mtg) e = q;
            const int mt = mtg - tab[e], c = (int)cnt[e], off = tab[64 + e];
            const int* rl = LIST + (size_t)e * T;
            const int hc0 = nt * GBN, tt = hc0 >> 7, w = hc0 & 127;
            const bf16_t* Bg = WTGU + ((size_t)e * 1024 + tt * 256 + w) * DM; const bf16_t* Bu = Bg + (size_t)128 * DM;
            auto epi = [&](int m, int n, f32x4 cg_, f32x4 cu_) {
                const float rs = RS1[rl[m] >> 1];
                f32x4 hv;
#pragma unroll
                for (int i = 0; i < 4; ++i) { const float g = cg_[i] * rs, uu = cu_[i] * rs; hv[i] = g * sigmoidf(g) * uu; }
                st_bf4(HID + (size_t)(off + m) * DEXP + hc0 + n, hv);
            };
            base_gemm_tile<2>(X1B, X1B, DM, rl, 1, c, Bg, Bu, DM, DM, mt * GBM, 0, ldsf, epi);
        }
        GRID_SYNC();
        constexpr int NNT_D = DM / GBN;
        for (int u = bid; u < nmt * NNT_D; u += G) {
            const int mtg = u / NNT_D, nt = u % NNT_D;
            int e = 0;
            for (int q = 1; q < NEXP; ++q) if (tab[q] <= mtg) e = q;
            const int mt = mtg - tab[e], c = (int)cnt[e], off = tab[64 + e];
            const int* rl = LIST + (size_t)e * T;
            const bf16_t* Ah = HID + (size_t)off * DEXP; const bf16_t* Bd = WTDN + (size_t)e * DM * DEXP;
            auto epi = [&](int m, int n, f32x4 cacc, f32x4) { const int as = rl[m]; st_bf4(YB + (size_t)as * DM + n, cacc * GW[as]); };
            base_gemm_tile<1>(Ah, Ah, DEXP, nullptr, 0, c, Bd, Bd, DEXP, DEXP, mt * GBM, nt * GBN, ldsf, epi);
        }
    }
    GRID_SYNC();
    { FRESH_IDS();
        float* X1 = (float*)(ws + WS_X1); bf16_t* X2B = (bf16_t*)(ws + WS_X1B); const bf16_t* YB = (const bf16_t*)(ws + WS_YB); float* RS2 = (float*)(ws + WS_RS2);
        for (int m = gw; m < T; m += NGW) {
            f32x4* xr = (f32x4*)(X1 + (size_t)m * DM) + lane;
            const u32x2* y0 = (const u32x2*)(YB + (size_t)(2 * m) * DM) + lane; const u32x2* y1 = (const u32x2*)(YB + (size_t)(2 * m + 1) * DM) + lane;
            u32x2* xb = (u32x2*)(X2B + (size_t)m * DM) + lane;
            float ss = 0.f;
#pragma unroll
            for (int j = 0; j < 8; ++j) {
                f32x4 v = xr[64 * j]; const u32x2 a0 = y0[64 * j], a1 = y1[64 * j];
                v.x += bflo(a0.x) + bflo(a1.x); v.y += bfhi(a0.x) + bfhi(a1.x); v.z += bflo(a0.y) + bflo(a1.y); v.w += bfhi(a0.y) + bfhi(a1.y);
                xr[64 * j] = v; u32x2 o; o.x = pk2(v.x, v.y); o.y = pk2(v.z, v.w); xb[64 * j] = o;
                ss += (v.x * v.x + v.y * v.y) + (v.z * v.z + v.w * v.w);
            }
            ss = wave_sum(ss);
            if (lane == 0) RS2[m] = 1.0f / sqrtf(ss * (1.0f / DM) + EPS);
        }
    }
    GRID_SYNC();
    if (FAST(8)) { FRESH_IDS();
        pg8::Gemm g{{(const bf16_t*)(ws + WS_X1B), nullptr}, {(const bf16_t*)(ws + WS_WTPG), nullptr}, DM};
        pg8::DenseOrder<1> S; S.init(T, DM, G, bid);
        if (G == 256) { EpiP8Fused E{(const float*)(ws + WS_X1), (const float*)(ws + WS_RS2), (const bf16_t*)(ws + WS_PLE), a.out, a.in[17], (float*)(ws + WS_SS),
                                     (unsigned*)(ws + WS_CTL) + CW_PANEL, (unsigned*)(ws + WS_CTL) + 2};
            pg8::gemm_phase<EpiP8Fused, pg8::DenseOrder<1>, false>(lds, g, S, E); }
        else { EpiP8 E{(const float*)(ws + WS_X1), (const float*)(ws + WS_RS2), (const bf16_t*)(ws + WS_PLE), a.out};
            pg8::gemm_phase<EpiP8, pg8::DenseOrder<1>, false>(lds, g, S, E); }
    }
    else { FRESH_IDS();
        const bf16_t* X2B = (const bf16_t*)(ws + WS_X1B); const bf16_t* WTPG = (const bf16_t*)(ws + WS_WTPG); const bf16_t* PLE = (const bf16_t*)(ws + WS_PLE);
        const float* X2 = (const float*)(ws + WS_X1); const float* RS2 = (const float*)(ws + WS_RS2); float* out = a.out;
        auto epi = [&](int m, int n, f32x4 c, f32x4) {
            const float rs = RS2[m]; const f32x4 pl = ld_bf4(PLE + (size_t)m * DM + n); const f32x4 xv = *(const f32x4*)(X2 + (size_t)m * DM + n);
            f32x4 o;
#pragma unroll
            for (int i = 0; i < 4; ++i) o[i] = xv[i] + sigmoidf(c[i] * rs) * pl[i];
            *(f32x4*)(out + (size_t)m * DM + n) = o;
        };
        constexpr int NMT = T / GBM, NNT = DM / GBN;
        for (int u = bid; u < NMT * NNT; u += G) { const int mt = u / NNT, nt = u % NNT;
            base_gemm_tile<1>(X2B, X2B, DM, nullptr, 0, T, WTPG, WTPG, DM, DM, mt * GBM, nt * GBN, ldsf, epi); }
    }
    if (!(FAST(8) && gridDim.x == 256)) {
    GRID_SYNC();
    { FRESH_IDS();
        float* out = a.out; const float* g_final = a.in[17];
        for (int m = gw; m < T; m += NGW) {
            f32x4* xr = (f32x4*)(out + (size_t)m * DM) + lane; const f32x4* gr = (const f32x4*)g_final + lane;
            f32x4 v[8]; float ss = 0.f;
#pragma unroll
            for (int j = 0; j < 8; ++j) { v[j] = xr[64 * j]; ss += (v[j].x * v[j].x + v[j].y * v[j].y) + (v[j].z * v[j].z + v[j].w * v[j].w); }
            ss = wave_sum(ss);
            const float rstd = 1.0f / sqrtf(ss * (1.0f / DM) + EPS);
#pragma unroll
            for (int j = 0; j < 8; ++j) xr[64 * j] = v[j] * rstd * gr[64 * j];
        }
    }
    }
}

extern "C" void kernel_launch(void* const* d_in, const int* in_sizes, int n_in, void* d_out, int out_size, void* d_ws, size_t ws_size, hipStream_t stream) {
    static int grid_blocks = 0;
    if (grid_blocks == 0) {
        if (n_in != 18 || out_size != T * DM || ws_size < WS_END) {
            fprintf(stderr, "kernel_launch: unexpected problem (n_in %d, out %d, ws %zu < %zu)\n", n_in, out_size, ws_size, (size_t)WS_END); grid_blocks = -1; return; }
        int dev = 0, cus = 0, per_cu = 0;
        (void)hipGetDevice(&dev);
        (void)hipDeviceGetAttribute(&cus, hipDeviceAttributeMultiprocessorCount, dev);
        (void)hipFuncSetAttribute((const void*)fwd_megakernel, hipFuncAttributeMaxDynamicSharedMemorySize, LDS_BYTES);
        (void)hipOccupancyMaxActiveBlocksPerMultiprocessor(&per_cu, (const void*)fwd_megakernel, NTHREADS, LDS_BYTES);
        if (per_cu < 1) { fprintf(stderr, "kernel_launch: occupancy query says %d blocks per CU\n", per_cu); per_cu = 1; }
        grid_blocks = cus * per_cu;
        fprintf(stderr, "kernel_launch: %d CUs x %d = %d workgroups, ws %zu bytes (need %zu)\n", cus, per_cu, grid_blocks, ws_size, (size_t)WS_END);
    }
    if (grid_blocks < 0) return;
    (void)hipMemsetAsync((char*)d_ws + WS_CTL, 0, CTL_BYTES, stream);
    Args a{};
    for (int i = 0; i < 18; ++i) a.in[i] = (const float*)d_in[i];
    a.out = (float*)d_out; a.ws = (unsigned char*)d_ws;
    void* args[] = {&a};
    hipError_t e = hipLaunchCooperativeKernel((const void*)fwd_megakernel, dim3(grid_blocks), dim3(NTHREADS), args, LDS_BYTES, stream);
    if (e != hipSuccess) fprintf(stderr, "cooperative launch failed: %s (grid %d)\n", hipGetErrorString(e), grid_blocks);
}
```

```cpp
#include <hip/hip_runtime.h>
#include <hip/hip_cooperative_groups.h>
#include <cstdio>
#include <cstdint>
namespace cg = cooperative_groups;

#define LAS __attribute__((address_space(3)))
typedef unsigned short bf16_t;
typedef float f32x4 __attribute__((ext_vector_type(4)));
typedef unsigned u32x4 __attribute__((ext_vector_type(4)));
typedef unsigned u32x2 __attribute__((ext_vector_type(2)));

constexpr int NBATCH = 2, SEQ = 4096, T = NBATCH * SEQ, DM = 2048, NH = 8, HD = 128, WA = NH * HD;
constexpr int DIN = 10248, NPROJ = 10240, NQKV = 6144, DPLE = 256, NEXP = 32, DEXP = 512;
constexpr float EPS = 1e-6f;
constexpr float QK_SCALE = 0.08838834764831845f;
constexpr int NWAVES = 8, NTHREADS = NWAVES * 64;

constexpr size_t MiB = 1u << 20;
constexpr size_t WS_CTL = 0, CTL_BYTES = 64 * 1024;
constexpr size_t WS_LF = 1 * MiB;
constexpr size_t WS_CUM = WS_LF + 256 * 1024;
constexpr size_t WS_RS1 = WS_CUM + 256 * 1024;
constexpr size_t WS_RS2 = WS_RS1 + 32 * 1024;
constexpr size_t WS_GW = WS_RS2 + 32 * 1024;
constexpr size_t WS_NB = 1 * MiB + 768 * 1024;
constexpr size_t WS_LIST = 2 * MiB;
constexpr size_t WS_PB = 4 * MiB;
constexpr size_t WS_WTIN = 8 * MiB;
constexpr size_t WS_WTBF = WS_WTIN + 40 * MiB;
constexpr size_t WS_WTBS = WS_WTBF + 4 * MiB;
constexpr size_t WS_WTMIX = WS_WTBS + 4 * MiB;
constexpr size_t WS_WTPG = WS_WTMIX + 8 * MiB;
constexpr size_t WS_WTPP = WS_WTPG + 8 * MiB;
constexpr size_t WS_WTGU = WS_WTPP + 1 * MiB;
constexpr size_t WS_WTDN = WS_WTGU + 128 * MiB;
constexpr size_t WS_H = WS_WTDN + 64 * MiB;
constexpr size_t WS_OA = WS_H, WS_OB = WS_H + 16 * MiB;
constexpr size_t WS_QKV = WS_H + 32 * MiB;
constexpr size_t WS_MIXED = WS_QKV, WS_X1B = WS_QKV + 32 * MiB, WS_HID = WS_QKV + 64 * MiB;
constexpr size_t WS_GATES = WS_QKV + 96 * MiB;
constexpr size_t WS_YB = WS_GATES;
constexpr size_t WS_X1 = WS_GATES + 64 * MiB;
constexpr size_t WS_PLE = WS_X1 + 64 * MiB;
constexpr size_t WS_OA2 = WS_PLE + 32 * MiB;
constexpr size_t WS_LSE1 = WS_OA2 + 16 * MiB, WS_LSE2 = WS_LSE1 + 256 * 1024;
constexpr size_t WS_SS = WS_LSE2 + 256 * 1024;
constexpr size_t WS_WRH = WS_SS + 256 * 1024, WS_WRL = WS_WRH + 256 * 1024;
constexpr size_t WS_NSQ = WS_WRL + 256 * 1024;
constexpr size_t WS_END = WS_NSQ + 2 * MiB;
constexpr int CW_CNT = 64, CW_QHEAD = 128;

#ifndef PHASE_MASK
#define PHASE_MASK 0xFFFF
#endif
#define PH(k) ((PHASE_MASK >> (k)) & 1)
#ifndef FAST_MASK
#define FAST_MASK 0xFFFF
#endif
#define FAST(k) ((FAST_MASK >> (k)) & 1)
constexpr int LDS_BYTES = 147456;

__device__ __forceinline__ unsigned f2bf(float f) { unsigned u = __builtin_bit_cast(unsigned, f); return (u + 0x7fffu + ((u >> 16) & 1u)) >> 16; }
typedef float f32x2_g __attribute__((ext_vector_type(2)));
typedef __bf16 bf16x2_g __attribute__((ext_vector_type(2)));
__device__ __forceinline__ unsigned pk2(float lo, float hi) { f32x2_g v = {lo, hi}; bf16x2_g b = __builtin_convertvector(v, bf16x2_g); return __builtin_bit_cast(unsigned, b); }
__device__ __forceinline__ float bflo(unsigned w) { return __builtin_bit_cast(float, w << 16); }
__device__ __forceinline__ float bfhi(unsigned w) { return __builtin_bit_cast(float, w & 0xffff0000u); }
__device__ __forceinline__ float bf2f(bf16_t h) { return __builtin_bit_cast(float, (unsigned)h << 16); }
__device__ __forceinline__ float wave_sum(float v) {
#pragma unroll
    for (int o = 1; o < 64; o <<= 1) v += __shfl_xor(v, o);
    return v;
}
__device__ __forceinline__ float wave_max(float v) {
#pragma unroll
    for (int o = 1; o < 64; o <<= 1) v = fmaxf(v, __shfl_xor(v, o));
    return v;
}
__device__ __forceinline__ float logsig(float x) { return fminf(x, 0.f) - log1pf(expf(-fabsf(x))); }
__device__ __forceinline__ float sigmoidf(float x) { return 1.f / (1.f + expf(-x)); }
#define LDS_WAIT() asm volatile("s_waitcnt lgkmcnt(0)" ::: "memory")

struct Args {
    const float* in[18];
    float* out;
    unsigned char* ws;
};

__device__ __forceinline__ void tr_load(const float* W, int ldw, int k0, int srccol0, const float* kscale, f32x4 (&v)[8], f32x4& g0, f32x4& g1, int lane) {
    { const bool hs = kscale != nullptr; const float* kp = hs ? kscale + k0 + 8 * (lane & 7) : W;
      const f32x4 t0 = *(const f32x4*)kp, t1 = *(const f32x4*)(kp + 4); const f32x4 one = {1.f, 1.f, 1.f, 1.f};
      g0 = hs ? t0 : one; g1 = hs ? t1 : one; }
    const float* wp = W + (size_t)(k0 + (lane >> 3)) * ldw + srccol0 + 4 * (lane & 7);
#pragma unroll
    for (int i = 0; i < 8; ++i) v[i] = *(const f32x4*)(wp + (size_t)(8 * i) * ldw);
}
__device__ __forceinline__ void tr_finish(f32x4 (&v)[8], f32x4 g0, f32x4 g1, int K, bf16_t* WT, int k0, LAS float* scr, int lane) {
#pragma unroll
    for (int i = 0; i < 8; ++i) { LAS float* d = scr + (8 * i + (lane >> 3)) * 33 + 4 * (lane & 7); d[0] = v[i].x; d[1] = v[i].y; d[2] = v[i].z; d[3] = v[i].w; }
    LDS_WAIT(); asm volatile("" ::: "memory");
    const int c = lane & 7;
#pragma unroll
    for (int j = 0; j < 4; ++j) {
        const int n = (lane >> 3) + 8 * j; const LAS float* s = scr + (8 * c) * 33 + n;
        u32x4 o; o.x = pk2(s[0 * 33] * g0.x, s[1 * 33] * g0.y); o.y = pk2(s[2 * 33] * g0.z, s[3 * 33] * g0.w); o.z = pk2(s[4 * 33] * g1.x, s[5 * 33] * g1.y); o.w = pk2(s[6 * 33] * g1.z, s[7 * 33] * g1.w);
        *(u32x4*)(WT + (size_t)n * K + k0 + 8 * c) = o;
    }
    LDS_WAIT(); asm volatile("" ::: "memory");
}
__device__ __forceinline__ void tr_item(const float* W, int ldw, int K, const float* kscale, bf16_t* WT, int k0, int srccol0, LAS float* scr, int lane) {
    f32x4 v[8]; f32x4 g0, g1; tr_load(W, ldw, k0, srccol0, kscale, v, g0, g1, lane); tr_finish(v, g0, g1, K, WT, k0, scr, lane);
}

constexpr int I_GU1 = (DM / 64) * (1024 / 32), I_DN1 = (DEXP / 64) * (DM / 32), I_BR = (WA / 64) * (DM / 32), I_SQ = (DM / 64) * (DM / 32), I_IN = (DM / 64) * (NPROJ / 32), I_PP = (DPLE / 64) * (DM / 32);
constexpr int N_Q_ITEMS = NEXP * (I_GU1 + I_DN1) + 2 * I_BR + 2 * I_SQ, N_P0_ITEMS = I_IN + I_PP, CONV_CHUNK = 64, N_CONV_CHUNKS = N_Q_ITEMS / CONV_CHUNK;
static_assert(N_Q_ITEMS % (CONV_CHUNK * 8) == 0, "conversion chunks divide over the 8 XCD queues");
struct ConvP { const float* W; const float* ks; bf16_t* WT; int ldw, K, k0, col; };
__device__ __forceinline__ ConvP conv_params(const Args& a, int r) {
    unsigned char* ws = a.ws; ConvP p;
    if (r < NEXP * I_GU1) {
        const int e = r / I_GU1, q = r % I_GU1, nblk = 1024 / 32, kb = q / nblk, nb = q % nblk, n0 = 32 * nb;
        const int t = n0 >> 8, w = n0 & 255; const bool up = w >= 128;
        p.W = (up ? a.in[12] : a.in[11]) + (size_t)e * DM * DEXP; p.ks = a.in[8]; p.WT = (bf16_t*)(ws + WS_WTGU) + ((size_t)e * 1024 + n0) * DM; p.ldw = DEXP; p.K = DM; p.k0 = 64 * kb; p.col = t * 128 + (w & 127); return p; }
    r -= NEXP * I_GU1;
    if (r < NEXP * I_DN1) {
        const int e = r / I_DN1, q = r % I_DN1, nblk = DM / 32, kb = q / nblk, nb = q % nblk;
        p.W = a.in[13] + (size_t)e * DEXP * DM; p.ks = nullptr; p.WT = (bf16_t*)(ws + WS_WTDN) + ((size_t)e * DM + 32 * nb) * DEXP; p.ldw = DM; p.K = DEXP; p.k0 = 64 * kb; p.col = 32 * nb; return p; }
    r -= NEXP * I_DN1;
    const int nblk = DM / 32;
    if (r < 2 * I_BR) { const int z = r / I_BR, q = r % I_BR, kb = q / nblk, nb = q % nblk;
        p.W = z ? a.in[5] : a.in[4]; p.ks = nullptr; p.WT = (bf16_t*)(ws + (z ? WS_WTBS : WS_WTBF)) + (size_t)(32 * nb) * WA; p.ldw = DM; p.K = WA; p.k0 = 64 * kb; p.col = 32 * nb; return p; }
    r -= 2 * I_BR;
    if (r < 2 * I_SQ) { const int z = r / I_SQ, q = r % I_SQ, kb = q / nblk, nb = q % nblk;
        p.W = z ? a.in[16] : a.in[6]; p.ks = z ? a.in[14] : nullptr; p.WT = (bf16_t*)(ws + (z ? WS_WTPG : WS_WTMIX)) + (size_t)(32 * nb) * DM; p.ldw = DM; p.K = DM; p.k0 = 64 * kb; p.col = 32 * nb; return p; }
    r -= 2 * I_SQ;
    if (r < I_IN) { const int nb2 = NPROJ / 32, kb = r / nb2, nb = r % nb2, n0 = 32 * nb;
        p.W = a.in[2]; p.ks = a.in[7]; p.WT = (bf16_t*)(ws + WS_WTIN) + (size_t)n0 * DM; p.ldw = DIN; p.K = DM; p.k0 = 64 * kb; p.col = n0 < 3072 ? n0 : n0 + 8; return p; }
    r -= I_IN;
    { const int kb = r / nblk, nb = r % nblk;
      p.W = a.in[15]; p.ks = nullptr; p.WT = (bf16_t*)(ws + WS_WTPP) + (size_t)(32 * nb) * DPLE; p.ldw = DM; p.K = DPLE; p.k0 = 64 * kb; p.col = 32 * nb; }
    return p;
}
__device__ __forceinline__ void conv_wave(const Args& a, int r0, int stride, int cnt, LAS float* scr, int lane) {
    f32x4 va[8], vb[8]; f32x4 ga0, ga1, gb0, gb1;
    ConvP pa, pb;
#define CV_LOAD(P, V, G0, G1, idx) do { P = conv_params(a, r0 + (idx) * stride); tr_load(P.W, P.ldw, P.k0, P.col, P.ks, V, G0, G1, lane); } while (0)
#define CV_FIN(P, V, G0, G1) tr_finish(V, G0, G1, P.K, P.WT, P.k0, scr, lane)
    if (cnt > 0) CV_LOAD(pa, va, ga0, ga1, 0);
#pragma unroll 1
    for (int q = 0; q < cnt; q += 2) {
        if (q + 1 < cnt) CV_LOAD(pb, vb, gb0, gb1, q + 1);
        CV_FIN(pa, va, ga0, ga1);
        if (q + 2 < cnt) CV_LOAD(pa, va, ga0, ga1, q + 2);
        if (q + 1 < cnt) CV_FIN(pb, vb, gb0, gb1);
    }
#undef CV_LOAD
#undef CV_FIN
}

__device__ __forceinline__ void p0_prologue(const Args& a, LAS unsigned char* lds, int gw, int NGW, int wave, int lane, int tid) {
    unsigned char* ws = a.ws;
    LAS float* scr = (LAS float*)(lds + wave * 8704);
    LAS float* wf = (LAS float*)(lds + 72 * 1024);
    const float* w_in = a.in[2]; const float* g_mix = a.in[7];
    for (int k = tid; k < DM; k += NTHREADS) { const float g = g_mix[k]; const f32x4 w0 = *(const f32x4*)(w_in + (size_t)k * DIN + 3072), w1 = *(const f32x4*)(w_in + (size_t)k * DIN + 3076);
        wf[0 * DM + k] = g * w0.x; wf[1 * DM + k] = g * w0.y; wf[2 * DM + k] = g * w0.z; wf[3 * DM + k] = g * w0.w; wf[4 * DM + k] = g * w1.x; wf[5 * DM + k] = g * w1.y; wf[6 * DM + k] = g * w1.z; wf[7 * DM + k] = g * w1.w; }
    { const int n = (N_P0_ITEMS - gw + NGW - 1) / NGW; if (n > 0) conv_wave(a, N_Q_ITEMS + gw, NGW, n, scr, lane); }
    __syncthreads();
    const float* x = a.in[0]; const float* b_forget = a.in[3];
    bf16_t* H = (bf16_t*)(ws + WS_H); float* LF = (float*)(ws + WS_LF);
    for (int m = gw; m < T; m += NGW) {
        const f32x4* xr = (const f32x4*)(x + (size_t)m * DM) + lane;
        float ss = 0.f;
#pragma unroll
        for (int j = 0; j < 8; ++j) { const f32x4 t = xr[64 * j]; ss += (t.x * t.x + t.y * t.y) + (t.z * t.z + t.w * t.w); }
        ss = wave_sum(ss);
        const float rstd = 1.0f / sqrtf(ss * (1.0f / DM) + EPS);
        u32x2* h8 = (u32x2*)(H + (size_t)m * DM) + lane;
        float f0 = 0, f1 = 0, f2 = 0, f3 = 0, f4 = 0, f5 = 0, f6 = 0, f7 = 0;
#pragma unroll 1
        for (int j = 0; j < 8; ++j) {
            const f32x4 v = xr[64 * j] * rstd;
            u32x2 o; o.x = pk2(v.x, v.y); o.y = pk2(v.z, v.w); h8[64 * j] = o;
            const LAS float* wp = wf + 256 * j + 4 * lane;
            const f32x4 a0 = *(const LAS f32x4*)(wp + 0 * DM), a1 = *(const LAS f32x4*)(wp + 1 * DM), a2 = *(const LAS f32x4*)(wp + 2 * DM), a3 = *(const LAS f32x4*)(wp + 3 * DM);
            const f32x4 a4 = *(const LAS f32x4*)(wp + 4 * DM), a5 = *(const LAS f32x4*)(wp + 5 * DM), a6 = *(const LAS f32x4*)(wp + 6 * DM), a7 = *(const LAS f32x4*)(wp + 7 * DM);
            f0 += v.x * a0.x + v.y * a0.y + v.z * a0.z + v.w * a0.w; f1 += v.x * a1.x + v.y * a1.y + v.z * a1.z + v.w * a1.w;
            f2 += v.x * a2.x + v.y * a2.y + v.z * a2.z + v.w * a2.w; f3 += v.x * a3.x + v.y * a3.y + v.z * a3.z + v.w * a3.w;
            f4 += v.x * a4.x + v.y * a4.y + v.z * a4.z + v.w * a4.w; f5 += v.x * a5.x + v.y * a5.y + v.z * a5.z + v.w * a5.w;
            f6 += v.x * a6.x + v.y * a6.y + v.z * a6.z + v.w * a6.w; f7 += v.x * a7.x + v.y * a7.y + v.z * a7.z + v.w * a7.w;
        }
        f0 = wave_sum(f0); f1 = wave_sum(f1); f2 = wave_sum(f2); f3 = wave_sum(f3); f4 = wave_sum(f4); f5 = wave_sum(f5); f6 = wave_sum(f6); f7 = wave_sum(f7);
        float sel = f0; sel = lane == 1 ? f1 : sel; sel = lane == 2 ? f2 : sel; sel = lane == 3 ? f3 : sel; sel = lane == 4 ? f4 : sel; sel = lane == 5 ? f5 : sel; sel = lane == 6 ? f6 : sel; sel = lane == 7 ? f7 : sel;
        if (lane < 8) LF[(size_t)m * 8 + lane] = logsig(sel + b_forget[lane]);
    }
    { const float* g_ffn = a.in[8]; const float* w_group = a.in[9]; const float* w_expert = a.in[10]; bf16_t* WRH = (bf16_t*)(ws + WS_WRH); bf16_t* WRL = (bf16_t*)(ws + WS_WRL);
      for (int idx = gw * 64 + lane; idx < 48 * DM; idx += NGW * 64) { const int c = idx / DM, k = idx % DM;
          const float v = c < 32 ? w_expert[(size_t)k * 32 + c] * g_ffn[k] : (c < 36 ? w_group[(size_t)k * 4 + (c - 32)] * g_ffn[k] : 0.f);
          const unsigned h = f2bf(v); const float r = v - __builtin_bit_cast(float, h << 16);
          WRH[idx] = (bf16_t)h; WRL[idx] = (bf16_t)f2bf(r); } }
    const float* p = a.in[1]; bf16_t* PB = (bf16_t*)(ws + WS_PB);
    for (int i = gw * 64 + lane; i < T * DPLE / 4; i += NGW * 64) {
        const f32x4 v = ((const f32x4*)p)[i]; u32x2 o; o.x = pk2(v.x, v.y); o.y = pk2(v.z, v.w); ((u32x2*)PB)[i] = o;
    }
    __syncthreads();
}

__device__ __forceinline__ void p_cumsum(const Args& a, LAS float* ldsf, int bid, int wave, int lane, int tid) {
    if (bid >= NBATCH) return;
    const float* LF = (const float*)(a.ws + WS_LF) + ((size_t)bid * SEQ + 8 * tid) * 8; float* CUM = (float*)(a.ws + WS_CUM); float* NBp = (float*)(a.ws + WS_NB);
    f32x4 v[8][2];
#pragma unroll
    for (int t = 0; t < 8; ++t) { v[t][0] = *(const f32x4*)(LF + t * 8); v[t][1] = *(const f32x4*)(LF + t * 8 + 4); }
#pragma unroll
    for (int t = 1; t < 8; ++t) { v[t][0] += v[t - 1][0]; v[t][1] += v[t - 1][1]; }
    f32x4 tot0 = v[7][0], tot1 = v[7][1], inc0 = tot0, inc1 = tot1;
#pragma unroll
    for (int o = 1; o < 64; o <<= 1) {
#pragma unroll
        for (int i = 0; i < 4; ++i) { const float u0 = __shfl_up(inc0[i], o), u1 = __shfl_up(inc1[i], o); if (lane >= o) { inc0[i] += u0; inc1[i] += u1; } } }
    if (lane == 63) { *(LAS f32x4*)(ldsf + wave * 8) = inc0; *(LAS f32x4*)(ldsf + wave * 8 + 4) = inc1; }
    __syncthreads();
    f32x4 off0 = inc0 - tot0, off1 = inc1 - tot1;
    for (int w = 0; w < wave; ++w) { off0 += *(LAS const f32x4*)(ldsf + w * 8); off1 += *(LAS const f32x4*)(ldsf + w * 8 + 4); }
    constexpr float NS = -1.0f / QK_SCALE;
#pragma unroll
    for (int h = 0; h < 8; ++h) {
        f32x4 c0, c1;
#pragma unroll
        for (int t = 0; t < 4; ++t) { c0[t] = (h < 4 ? v[t][0][h & 3] + off0[h & 3] : v[t][1][h & 3] + off1[h & 3]); c1[t] = (h < 4 ? v[t + 4][0][h & 3] + off0[h & 3] : v[t + 4][1][h & 3] + off1[h & 3]); }
        float* dc = CUM + (size_t)(bid * NH + h) * SEQ + 8 * tid; float* dn = NBp + (size_t)(bid * NH + h) * SEQ + 8 * tid;
        *(f32x4*)dc = c0; *(f32x4*)(dc + 4) = c1; *(f32x4*)dn = c0 * NS; *(f32x4*)(dn + 4) = c1 * NS;
    }
    __syncthreads();
}

constexpr int GBM = 128, GBN = 64, GBK = 32, LDA_S = 132, LDB_S = 68;
template <int NP, class Epi>
__device__ __forceinline__ void base_gemm_tile(const bf16_t* A0, const bf16_t* A1, int lda, const int* rowlist, int rshift, int nvalid,
                                               const bf16_t* B0, const bf16_t* B1, int ldb, int K, int m0, int n0, LAS float* lds, const Epi& epi) {
    const int tid = threadIdx.x, tm = tid >> 4, tn = tid & 15;
    LAS float* As = lds;
    LAS float* Bs = lds + NP * GBK * LDA_S;
    f32x4 acc[NP][4];
#pragma unroll
    for (int p = 0; p < NP; ++p)
#pragma unroll
        for (int i = 0; i < 4; ++i) acc[p][i] = (f32x4){0.f, 0.f, 0.f, 0.f};
    const int lr = tid >> 2, kc = (tid & 3) * 8;
    int ar = m0 + lr; if (ar > nvalid - 1) ar = nvalid - 1;
    if (rowlist) ar = rowlist[ar] >> rshift;
    for (int k0 = 0; k0 < K; k0 += GBK) {
#pragma unroll
        for (int p = 0; p < NP; ++p) {
            const bf16_t* Ap = p == 0 ? A0 : A1; const bf16_t* Bp = p == 0 ? B0 : B1;
            { const u32x4 w = *(const u32x4*)(Ap + (size_t)ar * lda + k0 + kc); LAS float* d = As + p * GBK * LDA_S + kc * LDA_S + lr;
              d[0 * LDA_S] = bflo(w.x); d[1 * LDA_S] = bfhi(w.x); d[2 * LDA_S] = bflo(w.y); d[3 * LDA_S] = bfhi(w.y);
              d[4 * LDA_S] = bflo(w.z); d[5 * LDA_S] = bfhi(w.z); d[6 * LDA_S] = bflo(w.w); d[7 * LDA_S] = bfhi(w.w); }
            if (tid < 256) { const u32x4 w = *(const u32x4*)(Bp + (size_t)(n0 + lr) * ldb + k0 + kc); LAS float* d = Bs + p * GBK * LDB_S + kc * LDB_S + lr;
              d[0 * LDB_S] = bflo(w.x); d[1 * LDB_S] = bfhi(w.x); d[2 * LDB_S] = bflo(w.y); d[3 * LDB_S] = bfhi(w.y);
              d[4 * LDB_S] = bflo(w.z); d[5 * LDB_S] = bfhi(w.z); d[6 * LDB_S] = bflo(w.w); d[7 * LDB_S] = bfhi(w.w); }
        }
        __syncthreads();
#pragma unroll
        for (int p = 0; p < NP; ++p) {
#pragma unroll 8
            for (int k = 0; k < GBK; ++k) {
                const f32x4 av = *(const LAS f32x4*)(As + p * GBK * LDA_S + k * LDA_S + tm * 4);
                const f32x4 bv = *(const LAS f32x4*)(Bs + p * GBK * LDB_S + k * LDB_S + tn * 4);
                acc[p][0] += av.x * bv; acc[p][1] += av.y * bv; acc[p][2] += av.z * bv; acc[p][3] += av.w * bv;
            }
        }
        __syncthreads();
    }
#pragma unroll
    for (int i = 0; i < 4; ++i) { const int m = m0 + tm * 4 + i; if (m < nvalid) epi(m, n0 + tn * 4, acc[0][i], acc[NP - 1][i]); }
}

__device__ __forceinline__ void st_bf4(bf16_t* p, f32x4 v) { u32x2 o; o.x = pk2(v.x, v.y); o.y = pk2(v.z, v.w); *(u32x2*)p = o; }
__device__ __forceinline__ f32x4 ld_bf4(const bf16_t* p) { const u32x2 w = *(const u32x2*)p; return (f32x4){bflo(w.x), bfhi(w.x), bflo(w.y), bfhi(w.y)}; }


namespace pg8 {
typedef short bf16x8 __attribute__((ext_vector_type(8)));
constexpr int BM = 256, BK = 64, HALF = 128, HTB = HALF * BK * 2, STAGE_BYTES = 8 * HTB, NXCD = 8, WGM = 8;
__device__ __forceinline__ int lds_byte(int r, int c) { const int st = (r >> 4) * 2 + (c >> 5), rr = r & 15, cc = c & 31, ob = rr * 64 + cc * 2; return st * 1024 + (ob ^ (((ob >> 9) & 1) << 5)); }
__device__ __forceinline__ void stage_rc(int b, int& R, int& C) { const int st = b / 1024, sb = b % 1024, swz = sb ^ (((sb >> 9) & 1) << 5); R = (st >> 1) * 16 + swz / 64; C = (st & 1) * 32 + (swz % 64) / 2; }
__device__ __forceinline__ int perm32(int rho) { const int n = rho >> 4, i = rho & 15; return 8 * (i >> 2) + 4 * n + (i & 3); }
struct Unit { int pm, pn, z; };
struct Gemm { const bf16_t* A[2]; const bf16_t* Bt[2]; int K; };
typedef float f32x2_t __attribute__((ext_vector_type(2))); typedef __bf16 bf16x2_t __attribute__((ext_vector_type(2)));
__device__ __forceinline__ unsigned cvt_pk_bf16(float lo, float hi) { f32x2_t v = {lo, hi}; bf16x2_t b = __builtin_convertvector(v, bf16x2_t); return __builtin_bit_cast(unsigned, b); }
__device__ __forceinline__ u32x4 pack8(f32x4 a, f32x4 b) { u32x4 w; w.x = cvt_pk_bf16(a[0], a[1]); w.y = cvt_pk_bf16(a[2], a[3]); w.z = cvt_pk_bf16(b[0], b[1]); w.w = cvt_pk_bf16(b[2], b[3]); return w; }

template <int Z> struct DenseOrder {
    int nM, nN, nwg, G, c;
    __device__ void init(int M, int N, int G_, int c_) { nM = M / BM; nN = N / BM; nwg = nM * nN; G = G_; c = c_; }
    __device__ __forceinline__ bool next(int i, Unit& u) const {
        const long L = (long)(i / Z) * G + c; if (L >= nwg) return false;
        int wgid = (int)L; { const int q = nwg / NXCD, r = nwg % NXCD, xcd = wgid % NXCD, off = wgid / NXCD; wgid = (xcd < r ? xcd * (q + 1) : r * (q + 1) + (xcd - r) * q) + off; }
        const int nig = WGM * nN, gid = wgid / nig, fm = gid * WGM, gsz = (nM - fm) < WGM ? (nM - fm) : WGM;
        u.pm = fm + ((wgid % nig) % gsz); u.pn = (wgid % nig) / gsz; u.z = i % Z; return true;
    }
    __device__ __forceinline__ int tok(int, int) const { return 0; }
};

template <class Epi, class Sched, bool GATHER>
__device__ __forceinline__ void gemm_phase(LAS unsigned char* lds, const Gemm g, const Sched& S, const Epi& E) {
    int tid = threadIdx.x; asm volatile("" : "+v"(tid));
    const int wid = __builtin_amdgcn_readfirstlane(tid >> 6), lane = tid & 63, wr = wid >> 2, wc = wid & 3, fr = lane & 15, fq = lane >> 4;
    const int K = g.K, nt = K / BK;
    unsigned voffB[2];
#pragma unroll
    for (int i = 0; i < 2; ++i) { int sR, sC; stage_rc(tid * 16 + i * 8192, sR, sC); const int Rb = (sR & ~31) + perm32(sR & 31); voffB[i] = (unsigned)(Rb * K + sC) * 2u; }
    const size_t kstep = (size_t)(BK * 2);
    const size_t hstep = (size_t)HALF * K * 2;
    const size_t tstep = 2 * hstep;
    const unsigned ldsw = (unsigned)wid * 1024u;
    const int aoff = lds_byte(wr * 64 + fr, fq * 8), boff = lds_byte(wc * 32 + fr, fq * 8);
#define PG8_SA(b, h) (((b) * 2 + (h)) * HTB)
#define PG8_SB(b, h) ((4 + (b) * 2 + (h)) * HTB)
#define PG8_STAGE2(bufoff, gbase, o0, o1) do { \
        __builtin_amdgcn_global_load_lds((const unsigned*)((const char*)(gbase) + (o0)), (LAS unsigned*)(lds + (bufoff) + ldsw), 16, 0, 0); \
        __builtin_amdgcn_global_load_lds((const unsigned*)((const char*)(gbase) + (o1)), (LAS unsigned*)(lds + (bufoff) + ldsw + 8192), 16, 0, 0); } while (0)
#define PG8_STAGEB(bufoff, gbase) PG8_STAGE2(bufoff, gbase, voffB[0], voffB[1])
#define PG8_LDA(dst, b, h) do { _Pragma("unroll") for (int m = 0; m < 4; ++m) _Pragma("unroll") for (int k = 0; k < 2; ++k) dst[m][k] = *(const LAS bf16x8*)(lds + PG8_SA(b, h) + aoff + m * 2048 + k * 1024); } while (0)
#define PG8_LDB(dst, b, h) do { _Pragma("unroll") for (int n = 0; n < 2; ++n) _Pragma("unroll") for (int k = 0; k < 2; ++k) dst[n][k] = *(const LAS bf16x8*)(lds + PG8_SB(b, h) + boff + n * 2048 + k * 1024); } while (0)
#define PG8_MMA(ai, bj, At, Bt) do { __builtin_amdgcn_s_setprio(1); _Pragma("unroll") for (int m = 0; m < 4; ++m) _Pragma("unroll") for (int n = 0; n < 2; ++n) _Pragma("unroll") for (int k = 0; k < 2; ++k) \
        acc[ai][bj][m][n] = __builtin_amdgcn_mfma_f32_16x16x32_bf16(Bt[n][k], At[m][k], acc[ai][bj][m][n], 0, 0, 0); __builtin_amdgcn_s_setprio(0); } while (0)
#ifdef PG8_CONSERVATIVE
#define PG8_WAIT_V(n) asm volatile("s_waitcnt vmcnt(0)" ::: "memory")
#else
#define PG8_WAIT_V(n) asm volatile("s_waitcnt vmcnt(" #n ")" ::: "memory")
#endif
#define PG8_WAIT_L(n) asm volatile("s_waitcnt lgkmcnt(" #n ")" ::: "memory")
#define PG8_BAR __builtin_amdgcn_s_barrier()
#define PG8_SCHED __builtin_amdgcn_sched_barrier(0)
#define PG8_AOFFS(dst, ui_) do { int t_ = threadIdx.x; asm volatile("" : "+v"(t_)); _Pragma("unroll") for (int i = 0; i < 2; ++i) { int R_, C_; stage_rc(t_ * 16 + i * 8192, R_, C_); \
        _Pragma("unroll") for (int h = 0; h < 2; ++h) { \
        if constexpr (GATHER) dst[h][i] = ((unsigned)S.tok(ui_, h * HALF + R_) * (unsigned)K + (unsigned)C_) * 2u; \
        else dst[h][i] = (unsigned)((h * HALF + R_) * K + C_) * 2u; } } } while (0)
    Unit cur, nxt; int ui = 0;
    if (!S.next(0, cur)) return;
    f32x4 acc[2][2][4][2];
#pragma unroll
    for (int a = 0; a < 2; ++a)
#pragma unroll
        for (int b = 0; b < 2; ++b)
#pragma unroll
            for (int m = 0; m < 4; ++m)
#pragma unroll
                for (int n = 0; n < 2; ++n) acc[a][b][m][n] = (f32x4){0.f, 0.f, 0.f, 0.f};
    bf16x8 At[4][2], B0[2][2], B1[2][2];
    unsigned vA[2][2];
    PG8_AOFFS(vA, 0);
    const char* cA = (const char*)(cur.z ? g.A[1] : g.A[0]) + (GATHER ? (size_t)0 : (size_t)cur.pm * tstep); const char* cB = (const char*)(cur.z ? g.Bt[1] : g.Bt[0]) + (size_t)cur.pn * tstep;
    PG8_STAGEB(PG8_SB(0, 0), cB); PG8_STAGEB(PG8_SB(0, 1), cB + hstep); PG8_STAGE2(PG8_SA(0, 0), cA, vA[0][0], vA[0][1]); PG8_STAGE2(PG8_SA(0, 1), cA, vA[1][0], vA[1][1]);
    if (wr == 1) PG8_BAR;
    PG8_WAIT_V(2); PG8_BAR;
    PG8_STAGEB(PG8_SB(1, 0), cB + kstep); PG8_STAGE2(PG8_SA(1, 0), cA + kstep, vA[0][0], vA[0][1]); PG8_STAGEB(PG8_SB(1, 1), cB + hstep + kstep);
    PG8_WAIT_V(6); PG8_BAR;
    for (;;) {
        const bool has_next = S.next(ui + 1, nxt);
        const char* nA = has_next ? (const char*)(nxt.z ? g.A[1] : g.A[0]) + (GATHER ? (size_t)0 : (size_t)nxt.pm * tstep) : cA; const char* nB = has_next ? (const char*)(nxt.z ? g.Bt[1] : g.Bt[0]) + (size_t)nxt.pn * tstep : cB;
#pragma unroll 1
        for (int t = 0; t < nt; t += 2) {
            const bool last = (t == nt - 2);
            const char* a1 = cA + (size_t)(t + 1) * kstep;
            const char* a2 = last ? nA : cA + (size_t)(t + 2) * kstep; const char* b2 = last ? nB : cB + (size_t)(t + 2) * kstep;
            const char* a3 = a2 + kstep; const char* b3 = b2 + kstep;
            unsigned v2[2][2];
#pragma unroll
            for (int h = 0; h < 2; ++h)
#pragma unroll
                for (int i = 0; i < 2; ++i) v2[h][i] = vA[h][i];
            if constexpr (GATHER) { if (last && has_next) { PG8_AOFFS(v2, ui + 1); } }
            PG8_LDB(B0, 0, 0); PG8_LDB(B1, 0, 1); PG8_SCHED; PG8_LDA(At, 0, 0); PG8_STAGE2(PG8_SA(1, 1), a1, vA[1][0], vA[1][1]);
            PG8_WAIT_V(8); PG8_WAIT_L(0); PG8_BAR; PG8_MMA(0, 0, At, B0); PG8_MMA(0, 1, At, B1); PG8_BAR; PG8_SCHED;
            PG8_LDA(At, 0, 1); PG8_STAGEB(PG8_SB(0, 0), b2); PG8_STAGEB(PG8_SB(0, 1), b2 + hstep); PG8_STAGE2(PG8_SA(0, 0), a2, v2[0][0], v2[0][1]);
            PG8_WAIT_V(8); PG8_WAIT_L(0); PG8_BAR; PG8_MMA(1, 0, At, B0); PG8_MMA(1, 1, At, B1); PG8_BAR; PG8_SCHED;
            PG8_LDB(B0, 1, 0); PG8_LDB(B1, 1, 1); PG8_SCHED; PG8_LDA(At, 1, 0); PG8_STAGE2(PG8_SA(0, 1), a2, v2[1][0], v2[1][1]);
            PG8_WAIT_V(8); PG8_WAIT_L(0); PG8_BAR; PG8_MMA(0, 0, At, B0); PG8_MMA(0, 1, At, B1); PG8_BAR; PG8_SCHED;
            PG8_LDA(At, 1, 1); PG8_STAGEB(PG8_SB(1, 0), b3); PG8_STAGEB(PG8_SB(1, 1), b3 + hstep); PG8_STAGE2(PG8_SA(1, 0), a3, v2[0][0], v2[0][1]);
            PG8_WAIT_V(8); PG8_WAIT_L(0); PG8_BAR; PG8_MMA(1, 0, At, B0); PG8_MMA(1, 1, At, B1); PG8_BAR; PG8_SCHED;
        }
        if (wr == 0) PG8_BAR;
        { int l2 = threadIdx.x; asm volatile("" : "+v"(l2)); E(acc, cur, ui, wr, wc, l2 & 15, (l2 >> 4) & 3, lds); }
        if (!has_next) break;
#pragma unroll
        for (int a = 0; a < 2; ++a)
#pragma unroll
            for (int b = 0; b < 2; ++b)
#pragma unroll
                for (int m = 0; m < 4; ++m)
#pragma unroll
                    for (int n = 0; n < 2; ++n) acc[a][b][m][n] = (f32x4){0.f, 0.f, 0.f, 0.f};
        cur = nxt; cA = nA; cB = nB; ++ui;
        if constexpr (GATHER) { PG8_AOFFS(vA, ui); }
        if (wr == 1) PG8_BAR;
    }
    PG8_WAIT_V(0);
    PG8_BAR;
#undef PG8_SA
#undef PG8_SB
#undef PG8_STAGE2
#undef PG8_STAGEB
#undef PG8_LDA
#undef PG8_LDB
#undef PG8_MMA
#undef PG8_WAIT_V
#undef PG8_WAIT_L
#undef PG8_BAR
#undef PG8_SCHED
#undef PG8_AOFFS
}
}


__device__ __forceinline__ float fast_sigmoid(float x) { return __builtin_amdgcn_rcpf(1.f + __builtin_amdgcn_exp2f(-1.4426950408889634f * x)); }
#define EPI_ROWS_BEGIN  _Pragma("unroll") for (int ai = 0; ai < 2; ++ai) _Pragma("unroll") for (int m = 0; m < 4; ++m) { const int rl_ = ai * 128 + wr * 64 + m * 16 + fr;
#define EPI_ROWS_END    asm volatile("" ::: "memory"); }
typedef f32x4 acc_t[2][2][4][2];

struct EpiP1 {
    bf16_t* QKV; bf16_t* GATES; float* NSQ;
    __device__ __forceinline__ void operator()(const acc_t& acc, const pg8::Unit& u, int, int wr, int wc, int fr, int fq, LAS unsigned char*) const {
        const int colt = u.pn * 256 + wc * 32 + 8 * fq;
        if (u.pn < 8) {
            EPI_ROWS_BEGIN const size_t row = (size_t)u.pm * 256 + rl_;
#pragma unroll
                for (int bj = 0; bj < 2; ++bj) { const f32x4 x0 = acc[ai][bj][m][0], x1 = acc[ai][bj][m][1];
                    *(u32x4*)(QKV + row * NQKV + colt + bj * 128) = pg8::pack8(x0, x1);
                    float sq = x0[0] * x0[0] + x0[1] * x0[1] + x0[2] * x0[2] + x0[3] * x0[3] + x1[0] * x1[0] + x1[1] * x1[1] + x1[2] * x1[2] + x1[3] * x1[3];
                    sq += __builtin_bit_cast(float, __builtin_amdgcn_ds_swizzle(__builtin_bit_cast(int, sq), 0x1F | (16 << 10)));
                    { auto rr = __builtin_amdgcn_permlane32_swap(__float_as_uint(sq), __float_as_uint(sq), false, false); sq = __uint_as_float(rr[0]) + __uint_as_float(rr[1]); }
                    if (fq == 0) NSQ[(size_t)((u.pn * 2 + bj) * 4 + wc) * T + row] = sq; }
            EPI_ROWS_END
        } else if (u.pn < 24) {
            EPI_ROWS_BEGIN const size_t row = (size_t)u.pm * 256 + rl_;
#pragma unroll
                for (int bj = 0; bj < 2; ++bj) *(u32x4*)(QKV + row * NQKV + colt + bj * 128) = pg8::pack8(acc[ai][bj][m][0], acc[ai][bj][m][1]);
            EPI_ROWS_END
        } else {
            EPI_ROWS_BEGIN const size_t row = (size_t)u.pm * 256 + rl_;
#pragma unroll
                for (int bj = 0; bj < 2; ++bj) { f32x4 a = acc[ai][bj][m][0], b = acc[ai][bj][m][1];
#pragma unroll
                    for (int i = 0; i < 4; ++i) { a[i] = fast_sigmoid(a[i]); b[i] = fast_sigmoid(b[i]); }
                    *(u32x4*)(GATES + row * 4096 + (colt - NQKV) + bj * 128) = pg8::pack8(a, b); }
            EPI_ROWS_END
        }
    }
};
struct EpiStoreBf {
    bf16_t* C; int ldc;
    __device__ __forceinline__ void operator()(const acc_t& acc, const pg8::Unit& u, int, int wr, int wc, int fr, int fq, LAS unsigned char*) const {
        const int colt = u.pn * 256 + wc * 32 + 8 * fq;
        EPI_ROWS_BEGIN const size_t row = (size_t)u.pm * 256 + rl_;
#pragma unroll
            for (int bj = 0; bj < 2; ++bj) *(u32x4*)(C + row * ldc + colt + bj * 128) = pg8::pack8(acc[ai][bj][m][0], acc[ai][bj][m][1]);
        EPI_ROWS_END
    }
};
__device__ __forceinline__ void unpack8(u32x4 w, f32x4& a, f32x4& b) { a = (f32x4){bflo(w.x), bfhi(w.x), bflo(w.y), bfhi(w.y)}; b = (f32x4){bflo(w.z), bfhi(w.z), bflo(w.w), bfhi(w.w)}; }
struct EpiP3 {
    const bf16_t* GATES; bf16_t* MIXED;
    __device__ __forceinline__ void operator()(const acc_t& acc, const pg8::Unit& u, int, int wr, int wc, int fr, int fq, LAS unsigned char*) const {
        const int colt = u.pn * 256 + wc * 32 + 8 * fq;
        EPI_ROWS_BEGIN const size_t row = (size_t)u.pm * 256 + rl_;
#pragma unroll
            for (int bj = 0; bj < 2; ++bj) { const int col = colt + bj * 128;
                f32x4 g0, g1; unpack8(*(const u32x4*)(GATES + row * 4096 + u.z * 2048 + col), g0, g1);
                f32x4 r0 = g0 * acc[ai][bj][m][0], r1 = g1 * acc[ai][bj][m][1];
                if (u.z == 1) { f32x4 p0, p1; unpack8(*(const u32x4*)(MIXED + row * DM + col), p0, p1); r0 += p0; r1 += p1; }
                *(u32x4*)(MIXED + row * DM + col) = pg8::pack8(r0, r1); }
        EPI_ROWS_END
    }
};
struct EpiP4 {
    const float* x; float* X1; bf16_t* X1B;
    __device__ __forceinline__ void operator()(const acc_t& acc, const pg8::Unit& u, int, int wr, int wc, int fr, int fq, LAS unsigned char*) const {
        const int colt = u.pn * 256 + wc * 32 + 8 * fq;
        EPI_ROWS_BEGIN const size_t row = (size_t)u.pm * 256 + rl_;
#pragma unroll
            for (int bj = 0; bj < 2; ++bj) { const size_t o = row * DM + colt + bj * 128;
                const f32x4 r0 = *(const f32x4*)(x + o) + acc[ai][bj][m][0], r1 = *(const f32x4*)(x + o + 4) + acc[ai][bj][m][1];
                *(f32x4*)(X1 + o) = r0; *(f32x4*)(X1 + o + 4) = r1; *(u32x4*)(X1B + o) = pg8::pack8(r0, r1); }
        EPI_ROWS_END
    }
};
struct EpiP8 {
    const bf16_t* X2B; const float* RS2; const bf16_t* PLE; float* out;
    __device__ __forceinline__ void operator()(const acc_t& acc, const pg8::Unit& u, int, int wr, int wc, int fr, int fq, LAS unsigned char*) const {
        const int colt = u.pn * 256 + wc * 32 + 8 * fq;
        EPI_ROWS_BEGIN const size_t row = (size_t)u.pm * 256 + rl_; const float rs = RS2[row];
#pragma unroll
            for (int bj = 0; bj < 2; ++bj) { const size_t o = row * DM + colt + bj * 128;
                f32x4 p0, p1; unpack8(*(const u32x4*)(PLE + o), p0, p1);
                f32x4 r0, r1; unpack8(*(const u32x4*)(X2B + o), r0, r1);
#pragma unroll
                for (int i = 0; i < 4; ++i) { r0[i] += fast_sigmoid(acc[ai][bj][m][0][i] * rs) * p0[i]; r1[i] += fast_sigmoid(acc[ai][bj][m][1][i] * rs) * p1[i]; }
                *(f32x4*)(out + o) = r0; *(f32x4*)(out + o + 4) = r1; }
        EPI_ROWS_END
    }
};


constexpr int CW_PANEL = 8192;
struct EpiP8Fused {
    const bf16_t* X2B; const float* RS2; const bf16_t* PLE; float* out; const float* g_final; float* SS  ; unsigned* pcnt; unsigned* tmo;
    __device__ __forceinline__ void operator()(const acc_t& acc_in, const pg8::Unit& u, int, int wr, int wc, int fr, int fq, LAS unsigned char* lds) const {
        acc_t& acc = const_cast<acc_t&>(acc_in);
        int tid = threadIdx.x; asm volatile("" : "+v"(tid)); const int lane = tid & 63, wid = __builtin_amdgcn_readfirstlane(tid >> 6);
        LAS float* P = (LAS float*)(lds + 131072); LAS float* S = P + 1024; LAS unsigned* flag = (LAS unsigned*)(S + 256);
        const int colt = u.pn * 256 + wc * 32 + 8 * fq;
        EPI_ROWS_BEGIN const size_t row = (size_t)u.pm * 256 + rl_; const float rs = RS2[row]; float sq = 0.f;
#pragma unroll
            for (int bj = 0; bj < 2; ++bj) { const size_t o = row * DM + colt + bj * 128;
                f32x4 p0, p1; unpack8(*(const u32x4*)(PLE + o), p0, p1);
                f32x4 r0, r1; unpack8(*(const u32x4*)(X2B + o), r0, r1);
#pragma unroll
                for (int i = 0; i < 4; ++i) { r0[i] += fast_sigmoid(acc[ai][bj][m][0][i] * rs) * p0[i]; r1[i] += fast_sigmoid(acc[ai][bj][m][1][i] * rs) * p1[i]; sq += r0[i] * r0[i] + r1[i] * r1[i]; }
                acc[ai][bj][m][0] = r0; acc[ai][bj][m][1] = r1; }
            sq += __shfl_xor(sq, 16); sq += __shfl_xor(sq, 32);
            if (fq == 0) P[rl_ * 4 + wc] = sq;
        EPI_ROWS_END
        asm volatile("s_waitcnt lgkmcnt(0)" ::: "memory"); __builtin_amdgcn_s_barrier(); asm volatile("" ::: "memory");
        if (tid < 256) { const f32x4 q = *(LAS const f32x4*)(P + tid * 4);
            __hip_atomic_store(SS + ((size_t)u.pm * 256 + tid) * 8 + u.pn, (q.x + q.y) + (q.z + q.w), __ATOMIC_RELAXED, __HIP_MEMORY_SCOPE_AGENT); }
        asm volatile("s_waitcnt vmcnt(0)" ::: "memory");
        if (wid < 4 && lane == 0) __hip_atomic_fetch_add(pcnt + 64 * u.pm, 1u, __ATOMIC_RELAXED, __HIP_MEMORY_SCOPE_AGENT);
        if (wid == 0) { unsigned sp = 0;
            while ((unsigned)__builtin_amdgcn_readfirstlane(__hip_atomic_load(pcnt + 64 * u.pm, __ATOMIC_RELAXED, __HIP_MEMORY_SCOPE_AGENT)) < 32u) {
                __builtin_amdgcn_s_sleep(2); if (++sp > (1u << 22)) { if (lane == 0) __hip_atomic_store(tmo, 1u, __ATOMIC_RELAXED, __HIP_MEMORY_SCOPE_AGENT); break; } }
            __builtin_amdgcn_fence(__ATOMIC_ACQUIRE, "agent"); }
        asm volatile("s_waitcnt vmcnt(0) lgkmcnt(0)" ::: "memory"); __builtin_amdgcn_s_barrier(); asm volatile("" ::: "memory");
        if (tid < 256) { const float* sl = SS + ((size_t)u.pm * 256 + tid) * 8; float t = 0.f;
#pragma unroll
            for (int k = 0; k < 8; ++k) t += __hip_atomic_load(sl + k, __ATOMIC_RELAXED, __HIP_MEMORY_SCOPE_AGENT);
            S[tid] = 1.0f / sqrtf(t * (1.0f / DM) + EPS); }
        asm volatile("s_waitcnt lgkmcnt(0)" ::: "memory"); __builtin_amdgcn_s_barrier(); asm volatile("" ::: "memory");
        f32x4 gv[2][2];
#pragma unroll
        for (int bj = 0; bj < 2; ++bj) { gv[bj][0] = *(const f32x4*)(g_final + colt + bj * 128); gv[bj][1] = *(const f32x4*)(g_final + colt + bj * 128 + 4); }
        EPI_ROWS_BEGIN const size_t row = (size_t)u.pm * 256 + rl_; const float rstd = S[rl_];
#pragma unroll
            for (int bj = 0; bj < 2; ++bj) { const size_t o = row * DM + colt + bj * 128;
                *(f32x4*)(out + o) = acc[ai][bj][m][0] * rstd * gv[bj][0]; *(f32x4*)(out + o + 4) = acc[ai][bj][m][1] * rstd * gv[bj][1]; }
        EPI_ROWS_END
    }
};


struct OneUnit {
    int pm, pn;
    __device__ __forceinline__ bool next(int i, pg8::Unit& u) const { if (i != 0) return false; u.pm = pm; u.pn = pn; u.z = 0; return true; }
    __device__ __forceinline__ int tok(int, int) const { return 0; }
};

constexpr int MOE_TAB_OFF = 131072, MOE_TOK_OFF = 131072 + 1024, MOE_MAXU = 6;
template <int NT> struct MoeOrder {
    LAS const int* tab; LAS const int* toks; int L0, Lend, stride, c;
    __device__ __forceinline__ void decode(int L, int& e, int& mt, int& nt_) const {
        const int mtg = L / NT; nt_ = L % NT; int ee = 0;
#pragma unroll 1
        for (int q = 1; q < NEXP; ++q) if (tab[q] <= mtg) ee = q;
        e = ee; mt = mtg - tab[ee];
    }
    __device__ __forceinline__ int unit(int i) const { const int L = L0 + c + i * stride; return (c < 0 || L >= Lend) ? -1 : L; }
    __device__ __forceinline__ bool next(int i, pg8::Unit& u) const {
        const int L = unit(i); if (L < 0) return false;
        int e, mt, nt_; decode(L, e, mt, nt_);
        u.pm = L / NT; u.pn = e * NT + nt_; u.z = 0; return true;
    }
    __device__ __forceinline__ int tok(int ui, int r) const { return toks[ui * 256 + r]; }
};
struct EpiGU {
    bf16_t* HID; const float* RS1; LAS const int* toks;
    __device__ __forceinline__ void operator()(const acc_t& acc, const pg8::Unit& u, int ui, int wr, int wc, int fr, int fq, LAS unsigned char*) const {
        const int hc = (u.pn & 3) * 128 + wc * 32 + 8 * fq;
        EPI_ROWS_BEGIN const float rs = RS1[toks[ui * 256 + rl_]];
            f32x4 h0, h1;
#pragma unroll
            for (int i = 0; i < 4; ++i) { const float g0 = acc[ai][0][m][0][i] * rs, u0 = acc[ai][1][m][0][i] * rs, g1 = acc[ai][0][m][1][i] * rs, u1 = acc[ai][1][m][1][i] * rs;
                h0[i] = g0 * fast_sigmoid(g0) * u0; h1[i] = g1 * fast_sigmoid(g1) * u1; }
            *(u32x4*)(HID + ((size_t)u.pm * 256 + rl_) * DEXP + hc) = pg8::pack8(h0, h1);
        EPI_ROWS_END
    }
};
struct EpiDN {
    bf16_t* YB; const float* GW; const int* LIST; LAS const int* tab;
    __device__ __forceinline__ void operator()(const acc_t& acc, const pg8::Unit& u, int, int wr, int wc, int fr, int fq, LAS unsigned char*) const {
        const int e = u.pn >> 3, mt = u.pm - tab[e], cnt = tab[64 + e];
        const int colt = (u.pn & 7) * 256 + wc * 32 + 8 * fq;
        EPI_ROWS_BEGIN const int r = mt * 256 + rl_;
            if (r < cnt) { const int as = LIST[(size_t)e * T + r]; const float gw = GW[as];
#pragma unroll
                for (int bj = 0; bj < 2; ++bj) *(u32x4*)(YB + (size_t)as * DM + colt + bj * 128) = pg8::pack8(acc[ai][bj][m][0] * gw, acc[ai][bj][m][1] * gw); }
        EPI_ROWS_END
    }
};


namespace att {
typedef short bf16x8 __attribute__((ext_vector_type(8)));
typedef short s16x4 __attribute__((ext_vector_type(4)));
typedef float f32x16 __attribute__((ext_vector_type(16)));
constexpr int QBLK = 32, KVBLK = 64, QB = 256, D = 128;
constexpr int SHM_V = KVBLK * D * 2, SHM_K = KVBLK * D * 2;
constexpr int NBUF = 2, OFF_V = 0, OFF_K = NBUF * SHM_V, OFF_WS = NBUF * (SHM_V + SHM_K), OFF_BIAS = OFF_WS + 8 * 64 * 4, OFF_FLAG = OFF_BIAS + NBUF * 64 * 4, ATT_LDS = OFF_FLAG + 16;
constexpr float SB_DONE = 150.f;
constexpr float SCALE = 0.08838834764831845f, C2 = 1.4426950408889634f * SCALE, THR = 8.f;
#define KSWZ(row, colB) ((row) * 256 + ((colB) ^ (((row) & 7) << 4)))
#define SBAR() __builtin_amdgcn_sched_barrier(0)
__device__ __forceinline__ int v_st(int k, int c) { const int kk = (k & ~0xC) | ((k & 4) << 1) | ((k & 8) >> 1); return ((kk >> 3) * 4 + (c >> 5)) * 512 + ((kk & 7) * 32 + (c & 31)) * 2; }
__device__ __forceinline__ int v_rd_base(int lane) { return ((lane & 3) << 3) | (((lane >> 2) & 3) << 6) | (((lane >> 4) & 1) << 5) | (((lane >> 5) & 1) << 8); }
constexpr int v_rd_off(int d0, int ks, int half) { return d0 * 512 + ks * 4096 + half * 2048; }
__device__ __forceinline__ int crow(int r, int hi) { return (r & 3) + 8 * (r >> 2) + 4 * hi; }
__device__ __forceinline__ unsigned cvtpk(float lo, float hi) { return pg8::cvt_pk_bf16(lo, hi); }
__device__ __forceinline__ bf16x8 ld8(const bf16_t* p) { return *reinterpret_cast<const bf16x8*>(p); }

template <int KB, bool PF = false>
__device__ __forceinline__ void qkt(f32x16& p0, f32x16& p1, LAS const char* K_lds, int r32, int hi, const bf16x8* qr) {
    p0 = f32x16{}; p1 = f32x16{};
    LAS const char* kb[4];
#pragma unroll
    for (int dd = 0; dd < 4; ++dd) kb[dd] = K_lds + KB * SHM_K + KSWZ(r32, (dd * 16 + hi * 8) * 2);
    if constexpr (PF) {
        bf16x8 fa[4][2], fb[4][2];
#pragma unroll
        for (int d0 = 0; d0 < 4; ++d0) { LAS const char* a = kb[d0 & 3]; fa[d0][0] = *reinterpret_cast<LAS const bf16x8*>(a); fa[d0][1] = *reinterpret_cast<LAS const bf16x8*>(a + 32 * 256); }
#pragma unroll
        for (int d0 = 0; d0 < 4; ++d0) { LAS const char* a = kb[d0 & 3] + 128; fb[d0][0] = *reinterpret_cast<LAS const bf16x8*>(a); fb[d0][1] = *reinterpret_cast<LAS const bf16x8*>(a + 32 * 256); }
#pragma unroll
        for (int d0 = 0; d0 < 4; ++d0) { p0 = __builtin_amdgcn_mfma_f32_32x32x16_bf16(fa[d0][0], qr[d0], p0, 0, 0, 0); p1 = __builtin_amdgcn_mfma_f32_32x32x16_bf16(fa[d0][1], qr[d0], p1, 0, 0, 0); }
#pragma unroll
        for (int d0 = 0; d0 < 4; ++d0) { p0 = __builtin_amdgcn_mfma_f32_32x32x16_bf16(fb[d0][0], qr[4 + d0], p0, 0, 0, 0); p1 = __builtin_amdgcn_mfma_f32_32x32x16_bf16(fb[d0][1], qr[4 + d0], p1, 0, 0, 0); }
    } else {
#pragma unroll
    for (int d0 = 0; d0 < 8; ++d0) { LAS const char* a = kb[d0 & 3] + (d0 >> 2) * 128;
        const bf16x8 b0 = *reinterpret_cast<LAS const bf16x8*>(a);
        const bf16x8 b1 = *reinterpret_cast<LAS const bf16x8*>(a + 32 * 256);
        p0 = __builtin_amdgcn_mfma_f32_32x32x16_bf16(b0, qr[d0], p0, 0, 0, 0);
        p1 = __builtin_amdgcn_mfma_f32_32x32x16_bf16(b1, qr[d0], p1, 0, 0, 0); }
    }
}
template <int VB>
__device__ __forceinline__ void pv_tile(f32x16* o, int vb0, bf16x8 pa0, bf16x8 pa1, bf16x8 pa2, bf16x8 pa3) {
#define TRRD(dst, off) asm volatile("ds_read_b64_tr_b16 %0, %1 offset:%2" : "=&v"(dst) : "v"(vb0), "i"(off) : "memory")
#define PV_D0(d0) do { s16x4 l0, l1, l2, l3, h0, h1, h2, h3; constexpr int b_ = OFF_V + VB * SHM_V + v_rd_off(d0, 0, 0); \
        TRRD(l0, b_); TRRD(h0, b_ + 2048); TRRD(l1, b_ + 4096); TRRD(h1, b_ + 6144); TRRD(l2, b_ + 8192); TRRD(h2, b_ + 10240); TRRD(l3, b_ + 12288); TRRD(h3, b_ + 14336); \
        asm volatile("s_waitcnt lgkmcnt(0)" ::: "memory"); SBAR(); \
        o[d0] = __builtin_amdgcn_mfma_f32_32x32x16_bf16(pa0, (bf16x8){l0[0], l0[1], l0[2], l0[3], h0[0], h0[1], h0[2], h0[3]}, o[d0], 0, 0, 0); \
        o[d0] = __builtin_amdgcn_mfma_f32_32x32x16_bf16(pa1, (bf16x8){l1[0], l1[1], l1[2], l1[3], h1[0], h1[1], h1[2], h1[3]}, o[d0], 0, 0, 0); \
        o[d0] = __builtin_amdgcn_mfma_f32_32x32x16_bf16(pa2, (bf16x8){l2[0], l2[1], l2[2], l2[3], h2[0], h2[1], h2[2], h2[3]}, o[d0], 0, 0, 0); \
        o[d0] = __builtin_amdgcn_mfma_f32_32x32x16_bf16(pa3, (bf16x8){l3[0], l3[1], l3[2], l3[3], h3[0], h3[1], h3[2], h3[3]}, o[d0], 0, 0, 0); } while (0)
    PV_D0(0); PV_D0(1); PV_D0(2); PV_D0(3);
#undef PV_D0
#undef TRRD
}
#define PK4(P, B_, OUT) do { const unsigned a0 = cvtpk(P[B_+0], P[B_+1]), a1 = cvtpk(P[B_+2], P[B_+3]), b0 = cvtpk(P[B_+4], P[B_+5]), b1 = cvtpk(P[B_+6], P[B_+7]); \
        auto r0 = __builtin_amdgcn_permlane32_swap(a0, b0, false, false); auto r1 = __builtin_amdgcn_permlane32_swap(a1, b1, false, false); \
        u32x4 w = {r0[0], r1[0], r0[1], r1[1]}; OUT = *reinterpret_cast<bf16x8*>(&w); } while (0)
__device__ __forceinline__ float xor1(float v) { return __builtin_bit_cast(float, __builtin_amdgcn_mov_dpp(__builtin_bit_cast(int, v), 0xB1, 0xF, 0xF, true)); }
__device__ __forceinline__ float xor2(float v) { return __builtin_bit_cast(float, __builtin_amdgcn_mov_dpp(__builtin_bit_cast(int, v), 0x4E, 0xF, 0xF, true)); }
template <int O> __device__ __forceinline__ float xorsw(float v) { return __builtin_bit_cast(float, __builtin_amdgcn_ds_swizzle(__builtin_bit_cast(int, v), 0x1F | (O << 10))); }
__device__ __forceinline__ float half_swap_add(float v) { auto rr = __builtin_amdgcn_permlane32_swap(__float_as_uint(v), __float_as_uint(v), false, false); return __uint_as_float(rr[0]) + __uint_as_float(rr[1]); }
__device__ __forceinline__ float half_swap_max(float v) { auto rr = __builtin_amdgcn_permlane32_swap(__float_as_uint(v), __float_as_uint(v), false, false); return fmaxf(__uint_as_float(rr[0]), __uint_as_float(rr[1])); }

template <int BR>
__device__ __forceinline__ void attn_unit(const bf16_t* Q, const bf16_t* K, const bf16_t* V, bf16_t* O, const float* NB, int P0, int t_begin, int t_end, float* LSE  , LAS char* lds) {
    constexpr int LDK = NQKV, LDO = WA;
    int tid = threadIdx.x; asm volatile("" : "+v"(tid));
    const int wid = __builtin_amdgcn_readfirstlane(tid >> 6), lane = tid & 63, r32 = lane & 31, hi = lane >> 5;
    const int NTF = P0 / KVBLK + 4;
    const int NT = t_end - t_begin;
    const int qlo = P0 + wid * QBLK, qpos = qlo + r32 - (BR ? 1 : 0);
    LAS char* V_lds = lds + OFF_V; LAS char* K_lds = lds + OFF_K;
    LAS float* wsf = (LAS float*)(lds + OFF_WS) + wid * 64; LAS float* BIAS = (LAS float*)(lds + OFF_BIAS); LAS unsigned* FLAG = (LAS unsigned*)(lds + OFF_FLAG);
    const int sr = tid >> 4, sc = (tid & 15) * 8, vst0 = v_st(sr, sc), vst1 = v_st(32 + sr, sc), kws = KSWZ(sr, sc * 2);
    const int vb0 = (int)(uintptr_t)(lds) + v_rd_base(lane);
    bf16x8 qr[8];
#pragma unroll
    for (int d0 = 0; d0 < 8; ++d0) qr[d0] = ld8(Q + (size_t)(wid * QBLK + r32) * LDK + d0 * 16 + hi * 8);
    bf16x8 st_v0, st_v1, st_k0, st_k1; f32x4 st_b = {0.f, 0.f, 0.f, 0.f};
#define KBASE(t) (BR ? (NTF - 1 - (t)) * KVBLK : (t_begin + (t)) * KVBLK)
#define SLOAD(t) do { const int k0_ = KBASE(t); st_v0 = ld8(V + (size_t)(k0_ + sr) * LDK + sc); st_v1 = ld8(V + (size_t)(k0_ + 32 + sr) * LDK + sc); \
        st_k0 = ld8(K + (size_t)(k0_ + sr) * LDK + sc); st_k1 = ld8(K + (size_t)(k0_ + 32 + sr) * LDK + sc); \
        if (BR == 0 && tid < 16) st_b = *(const f32x4*)(NB + k0_ + tid * 4); } while (0)
#define SWRITE(bf) do { *(LAS bf16x8*)(K_lds + (bf) * SHM_K + kws) = st_k0; *(LAS bf16x8*)(K_lds + (bf) * SHM_K + kws + 32 * 256) = st_k1; \
        *(LAS bf16x8*)(V_lds + (bf) * SHM_V + vst0) = st_v0; *(LAS bf16x8*)(V_lds + (bf) * SHM_V + vst1) = st_v1; \
        if (BR == 0 && tid < 16) *(LAS f32x4*)(BIAS + (bf) * 64 + tid * 4) = st_b; } while (0)
#define VMW() asm volatile("s_waitcnt vmcnt(0)" ::: "memory")
    f32x16 o[4] = {};
    float m_reg = -1e30f, l_reg = 0.f, carry = 0.f, carry_min = 0.f;
    bf16x8 U0, U1;
    if (BR) { u32x4 w0, w1;
#pragma unroll
        for (int jj = 0; jj < 4; ++jj) { unsigned a = 0, b = 0;
#pragma unroll
            for (int e = 0; e < 2; ++e) { const int j = 2 * jj + e; const int k0 = 8 * (j >> 2) + 4 * hi + (j & 3), k1 = 16 + k0;
                a |= (k0 > r32 ? 0x3F80u : 0u) << (16 * e); b |= (k1 > r32 ? 0x3F80u : 0u) << (16 * e); }
            w0[jj] = a; w1[jj] = b; }
        U0 = *reinterpret_cast<bf16x8*>(&w0); U1 = *reinterpret_cast<bf16x8*>(&w1); }
    if (BR && tid < 3) FLAG[tid] = 0u;
    SLOAD(0); VMW(); SWRITE(0); if (NT > 1) SLOAD(1);
    __syncthreads();
    bool alldone = false;
#define STEP(t, BUF) do { \
        if ((t) + 1 < NT) { VMW(); SWRITE((BUF) ^ 1); } \
        if ((t) + 2 < NT) SLOAD((t) + 2); \
        SBAR(); \
        const int kb_ = KBASE(t); \
        const bool act_ = BR ? (kb_ <= qlo + QBLK - 2 && carry_min < SB_DONE) : (kb_ <= qlo + QBLK - 1);     \
        if (act_) { \
        f32x16 p0, p1; qkt<BUF>(p0, p1, K_lds, r32, hi, qr); \
        bf16x8 pa0, pa1, pa2, pa3; \
        if (BR == 0) { \
            _Pragma("unroll") for (int g = 0; g < 4; ++g) { const f32x4 b0 = *(LAS const f32x4*)(BIAS + (BUF) * 64 + 8 * g + 4 * hi), b1 = *(LAS const f32x4*)(BIAS + (BUF) * 64 + 32 + 8 * g + 4 * hi); \
                _Pragma("unroll") for (int i = 0; i < 4; ++i) { p0[4 * g + i] += b0[i]; p1[4 * g + i] += b1[i]; } } \
            if (kb_ + KVBLK - 1 > qlo) { const float NEG = -__builtin_inff(); \
                _Pragma("unroll") for (int r = 0; r < 16; ++r) { const int key = kb_ + crow(r, hi); if (key > qpos) p0[r] = NEG; if (key + 32 > qpos) p1[r] = NEG; } } \
            float pmax = p0[0]; _Pragma("unroll") for (int r = 1; r < 16; ++r) pmax = fmaxf(pmax, p0[r]); _Pragma("unroll") for (int r = 0; r < 16; ++r) pmax = fmaxf(pmax, p1[r]); \
            pmax = half_swap_max(pmax); \
            float alpha = 1.f; \
            if (!__all((pmax - m_reg) * SCALE <= THR)) { const float mn = fmaxf(m_reg, pmax); alpha = __builtin_amdgcn_exp2f((m_reg - mn) * C2); m_reg = mn; } \
            const float mnL = -m_reg * C2; float ps = 0.f; \
            _Pragma("unroll") for (int r = 0; r < 16; ++r) { p0[r] = __builtin_amdgcn_exp2f(fmaf(p0[r], C2, mnL)); p1[r] = __builtin_amdgcn_exp2f(fmaf(p1[r], C2, mnL)); } \
            _Pragma("unroll") for (int r = 0; r < 16; ++r) ps += p0[r] + p1[r]; \
            ps = half_swap_add(ps); l_reg = l_reg * alpha + ps; \
            if (__any(alpha < 1.f)) { if (hi == 0) wsf[r32] = alpha; asm volatile("s_waitcnt lgkmcnt(0)" ::: "memory"); \
                _Pragma("unroll") for (int r = 0; r < 16; ++r) { const float al = wsf[crow(r, hi)]; o[0][r] *= al; o[1][r] *= al; o[2][r] *= al; o[3][r] *= al; } } \
        } else { \
            const float NEG = -__builtin_inff(); const bool msk = kb_ + KVBLK - 1 > qlo - 1; \
            _Pragma("unroll") for (int r = 0; r < 16; ++r) { const int key = kb_ + crow(r, hi); float z0 = p0[r] * C2, z1 = p1[r] * C2; \
                if (msk) { if (key > qpos) z0 = NEG; if (key + 32 > qpos) z1 = NEG; } p0[r] = z0; p1[r] = z1; } \
            f32x16 s0, s1; float t0 = 0.f, t1 = 0.f; \
            _Pragma("unroll") for (int r = 0; r < 16; ++r) { s0[r] = __builtin_amdgcn_logf(1.f + __builtin_amdgcn_exp2f(p0[r])); s1[r] = __builtin_amdgcn_logf(1.f + __builtin_amdgcn_exp2f(p1[r])); t0 += s0[r]; t1 += s1[r]; } \
            t0 = half_swap_add(t0); t1 = half_swap_add(t1); \
            bf16x8 x00, x01, x10, x11; \
            { u32x4 w = {cvtpk(s0[0], s0[1]), cvtpk(s0[2], s0[3]), cvtpk(s0[4], s0[5]), cvtpk(s0[6], s0[7])}; x00 = *reinterpret_cast<bf16x8*>(&w); } \
            { u32x4 w = {cvtpk(s0[8], s0[9]), cvtpk(s0[10], s0[11]), cvtpk(s0[12], s0[13]), cvtpk(s0[14], s0[15])}; x01 = *reinterpret_cast<bf16x8*>(&w); } \
            { u32x4 w = {cvtpk(s1[0], s1[1]), cvtpk(s1[2], s1[3]), cvtpk(s1[4], s1[5]), cvtpk(s1[6], s1[7])}; x10 = *reinterpret_cast<bf16x8*>(&w); } \
            { u32x4 w = {cvtpk(s1[8], s1[9]), cvtpk(s1[10], s1[11]), cvtpk(s1[12], s1[13]), cvtpk(s1[14], s1[15])}; x11 = *reinterpret_cast<bf16x8*>(&w); } \
            const float c0 = carry + t1, c1 = carry; carry += t0 + t1; \
            { f32x16 y0 = {}; y0 = __builtin_amdgcn_mfma_f32_32x32x16_bf16(U0, x00, y0, 0, 0, 0); y0 = __builtin_amdgcn_mfma_f32_32x32x16_bf16(U1, x01, y0, 0, 0, 0); \
              _Pragma("unroll") for (int r = 0; r < 16; ++r) p0[r] = __builtin_amdgcn_exp2f(p0[r] - s0[r] - y0[r] - c0); } \
            SBAR(); \
            { f32x16 y1 = {}; y1 = __builtin_amdgcn_mfma_f32_32x32x16_bf16(U0, x10, y1, 0, 0, 0); y1 = __builtin_amdgcn_mfma_f32_32x32x16_bf16(U1, x11, y1, 0, 0, 0); \
              _Pragma("unroll") for (int r = 0; r < 16; ++r) p1[r] = __builtin_amdgcn_exp2f(p1[r] - s1[r] - y1[r] - c1); } \
            { float cm = carry; cm = fminf(cm, xor1(cm)); cm = fminf(cm, xor2(cm)); cm = fminf(cm, xorsw<4>(cm)); cm = fminf(cm, xorsw<8>(cm)); cm = fminf(cm, xorsw<16>(cm)); carry_min = cm; } \
        } \
        PK4(p0, 0, pa0); PK4(p0, 8, pa1); PK4(p1, 0, pa2); PK4(p1, 8, pa3); \
        SBAR(); pv_tile<BUF>(o, vb0, pa0, pa1, pa2, pa3); } \
        if (BR) { if (lane == 0) { if (carry_min < SB_DONE) __hip_atomic_fetch_add(&FLAG[(t) % 3], 1u, __ATOMIC_RELAXED, __HIP_MEMORY_SCOPE_WORKGROUP); } if (tid == 0) FLAG[((t) + 1) % 3] = 0u; } \
        __syncthreads(); \
        if (BR) { alldone = FLAG[(t) % 3] == 0u; } } while (0)
    if constexpr (BR == 1) {
    int t = 0;
    for (; t + 1 < NT; t += 2) { STEP(t, 0); if (BR && alldone) break; STEP(t + 1, 1); if (BR && alldone) break; }
    if (!(BR && alldone) && t < NT) { STEP(t, 0); }
    } else {
#define ACTF(t) (KBASE(t) <= qlo + QBLK - 1)
#define QKTF(KB, P0, P1, t) qkt<KB, false>(P0, P1, K_lds, r32, hi, qr)
#define PARTIALF(P0, P1, BUF, t, mnX, alX) do { const int kb_ = KBASE(t); \
        _Pragma("unroll") for (int g = 0; g < 4; ++g) { const f32x4 b0 = *(LAS const f32x4*)(BIAS + (BUF) * 64 + 8 * g + 4 * hi), b1 = *(LAS const f32x4*)(BIAS + (BUF) * 64 + 32 + 8 * g + 4 * hi); \
            _Pragma("unroll") for (int i = 0; i < 4; ++i) { P0[4 * g + i] += b0[i]; P1[4 * g + i] += b1[i]; } } \
        if (kb_ + KVBLK - 1 > qlo) { const float NEG = -__builtin_inff(); \
            _Pragma("unroll") for (int r = 0; r < 16; ++r) { const int key = kb_ + crow(r, hi); if (key > qpos) P0[r] = NEG; if (key + 32 > qpos) P1[r] = NEG; } } \
        float pmax = P0[0]; _Pragma("unroll") for (int r = 1; r < 16; ++r) pmax = fmaxf(pmax, P0[r]); _Pragma("unroll") for (int r = 0; r < 16; ++r) pmax = fmaxf(pmax, P1[r]); \
        pmax = half_swap_max(pmax); \
        if (__builtin_expect(__all((pmax - m_reg) * SCALE <= THR), 1)) { alX = 1.f; } \
        else { const float mn_ = fmaxf(m_reg, pmax); alX = __builtin_amdgcn_exp2f((m_reg - mn_) * C2); m_reg = mn_; } \
        const float mnL = -m_reg * C2; \
        _Pragma("unroll") for (int r = 0; r < 16; ++r) { P0[r] = fmaf(P0[r], C2, mnL); P1[r] = fmaf(P1[r], C2, mnL); } \
        _Pragma("unroll") for (int r = 0; r < 16; ++r) P0[r] = __builtin_amdgcn_exp2f(P0[r]); } while (0)
#define FINISHF(P0, P1, alY) do { _Pragma("unroll") for (int r = 0; r < 16; ++r) P1[r] = __builtin_amdgcn_exp2f(P1[r]); \
        float ps = 0.f; _Pragma("unroll") for (int r = 0; r < 16; ++r) ps += P0[r]; _Pragma("unroll") for (int r = 0; r < 16; ++r) ps += P1[r]; \
        ps = half_swap_add(ps); l_reg = l_reg * (alY) + ps; \
        PK4(P0, 0, pa0); PK4(P0, 8, pa1); PK4(P1, 0, pa2); PK4(P1, 8, pa3); } while (0)
#define RESCF(a_) do { if (__any((a_) < 1.f)) { if (hi == 0) wsf[32 + r32] = (a_); asm volatile("s_waitcnt lgkmcnt(0)" ::: "memory"); \
        _Pragma("unroll") for (int d_ = 0; d_ < 4; ++d_) _Pragma("unroll") for (int r = 0; r < 16; ++r) o[d_][r] *= wsf[32 + crow(r, hi)]; } } while (0)
#define PVF(VB, t) pv_tile<VB>(o, vb0, pa0, pa1, pa2, pa3)
    f32x16 pA0, pA1, pB0, pB1; float mnA = 0.f, mnB = 0.f, alA, alB; bf16x8 pa0, pa1, pa2, pa3; (void)mnA; (void)mnB;
    SBAR(); QKTF(0, pA0, pA1, 0);
    PARTIALF(pA0, pA1, 0, 0, mnA, alA);
    if (NT > 1) { VMW(); SWRITE(1); if (NT > 2) SLOAD(2); }
    RESCF(alA);
    __syncthreads();
#define HSF(PX0, PX1, mnX, alX, PY0, PY1, alY, t, KB, VB, SB) do { \
        SBAR(); QKTF(KB, PX0, PX1, t); \
        FINISHF(PY0, PY1, alY); \
        _Pragma("unroll") for (int i_ = 0; i_ < 8; ++i_) { __builtin_amdgcn_sched_group_barrier(0x100, 2, 0); __builtin_amdgcn_sched_group_barrier(0x8, 2, 0); __builtin_amdgcn_sched_group_barrier(0x2, 12, 0); } \
        SBAR(); \
        PVF(VB, (t) - 1); PARTIALF(PX0, PX1, KB, t, mnX, alX); \
        __syncthreads(); \
        if ((t) + 1 < NT) { VMW(); SWRITE(SB); if ((t) + 2 < NT) SLOAD((t) + 2); } \
        RESCF(alX); __syncthreads(); } while (0)
    int t = 1;
    for (; t + 1 < NT; t += 2) {
        HSF(pB0, pB1, mnB, alB, pA0, pA1, alA, t, 1, 0, 0);
        HSF(pA0, pA1, mnA, alA, pB0, pB1, alB, t + 1, 0, 1, 1);
    }
    if (t < NT) { HSF(pB0, pB1, mnB, alB, pA0, pA1, alA, t, 1, 0, 0); SBAR(); FINISHF(pB0, pB1, alB); SBAR(); PVF(1, t); }
    else { SBAR(); FINISHF(pA0, pA1, alA); SBAR(); PVF(0, t - 1); }
    __syncthreads();
#undef HSF
#undef PVF
#undef RESCF
#undef FINISHF
#undef PARTIALF
#undef QKTF
#undef ACTF
    }
    float rli[16];
    { int t3 = threadIdx.x; asm volatile("" : "+v"(t3)); const int r32e = t3 & 31, hie = (t3 >> 5) & 1;
    if (BR == 0 && LSE) { if (hie == 0) LSE[(size_t)(wid * QBLK + r32e) * 8] = m_reg * C2 + __builtin_amdgcn_logf(l_reg); } }
    if (BR == 0) { if (hi == 0) wsf[r32] = l_reg; asm volatile("s_waitcnt lgkmcnt(0)" ::: "memory");
#pragma unroll
        for (int r = 0; r < 16; ++r) rli[r] = __builtin_amdgcn_rcpf(wsf[crow(r, hi)]); }
    else {
#pragma unroll
        for (int r = 0; r < 16; ++r) rli[r] = 1.f; }
    { int t4 = threadIdx.x; asm volatile("" : "+v"(t4)); const int r32e = t4 & 31, hie = (t4 >> 5) & 1;
    bf16_t* Ow = O + (size_t)(wid * QBLK) * LDO;
#pragma unroll
    for (int r = 0; r < 16; ++r) { const int orow = crow(r, hie);
#pragma unroll
        for (int d0 = 0; d0 < 4; ++d0) { const float v = o[d0][r] * rli[r]; const float vn = xor1(v);
            if ((r32e & 1) == 0) *(unsigned*)(Ow + (size_t)orow * LDO + d0 * 32 + r32e) = cvtpk(v, vn); } } }
    __syncthreads();
#undef STEP
#undef KBASE
#undef SLOAD
#undef SWRITE
#undef VMW
}
#undef PK4
}

__device__ __forceinline__ void base_attn_row(const Args& a, int br, int b, int h, int t, LAS float* S, LAS float* qs, int lane) {
    const bf16_t* QKV = (const bf16_t*)(a.ws + WS_QKV);
    const bf16_t* Qp = QKV + (size_t)(b * SEQ + t) * NQKV + br * 3072 + h * HD;
    const bf16_t* Kp = QKV + (size_t)(b * SEQ) * NQKV + br * 3072 + 1024 + h * HD;
    const bf16_t* Vp = QKV + (size_t)(b * SEQ) * NQKV + br * 3072 + 2048 + h * HD;
    const float* CUM = (const float*)(a.ws + WS_CUM) + (size_t)(b * NH + h) * SEQ;
    bf16_t* O = (bf16_t*)(a.ws + (br == 0 ? WS_OA : WS_OB)) + (size_t)(b * SEQ + t) * WA + h * HD;
    { const unsigned w = *(const unsigned*)(Qp + 2 * lane); qs[2 * lane] = bflo(w); qs[2 * lane + 1] = bfhi(w); }
    LDS_WAIT(); asm volatile("" ::: "memory");
    const int n = br == 0 ? t + 1 : t;
    float mx = -1e30f;
    for (int j0 = 0; j0 < n; j0 += 64) {
        const int j = j0 + lane; const int jc = j < n ? j : n - 1;
        const bf16_t* kr = Kp + (size_t)jc * NQKV;
        float d = 0.f;
#pragma unroll 4
        for (int c = 0; c < 16; ++c) {
            const u32x4 w = *(const u32x4*)(kr + 8 * c);
            const f32x4 q0 = *(const LAS f32x4*)(qs + 8 * c), q1 = *(const LAS f32x4*)(qs + 8 * c + 4);
            d += bflo(w.x) * q0.x + bfhi(w.x) * q0.y + bflo(w.y) * q0.z + bfhi(w.y) * q0.w + bflo(w.z) * q1.x + bfhi(w.z) * q1.y + bflo(w.w) * q1.z + bfhi(w.w) * q1.w;
        }
        float s = d * QK_SCALE;
        if (br == 0) s -= CUM[jc];
        if (j < n) { S[j] = s; mx = fmaxf(mx, s); }
    }
    LDS_WAIT(); asm volatile("" ::: "memory");
    float inv = 1.f;
    if (br == 0) {
        mx = wave_max(mx);
        float l = 0.f;
        for (int j = lane; j < n; j += 64) { const float e = expf(S[j] - mx); S[j] = e; l += e; }
        l = wave_sum(l); inv = 1.f / l;
    } else {
        float carry = 0.f;
        const int nch = (n + 63) / 64;
        for (int c = nch - 1; c >= 0; --c) {
            const int j = c * 64 + lane; const bool valid = j < n;
            const float z = valid ? S[j] : 0.f;
            const float L = valid ? logsig(-z) : 0.f;
            float incl = L;
#pragma unroll
            for (int o = 1; o < 64; o <<= 1) { const float tt = __shfl_down(incl, o); if (lane + o < 64) incl += tt; }
            const float after = carry + (incl - L);
            if (valid) S[j] = expf(logsig(z) + after);
            carry += __shfl(incl, 0);
        }
    }
    LDS_WAIT(); asm volatile("" ::: "memory");
    float o0 = 0.f, o1 = 0.f;
    const bf16_t* vp = Vp + 2 * lane;
#pragma unroll 8
    for (int j = 0; j < n; ++j) { const float p = S[j]; const unsigned w = *(const unsigned*)(vp + (size_t)j * NQKV); o0 += p * bflo(w); o1 += p * bfhi(w); }
    *(unsigned*)(O + 2 * lane) = pk2(o0 * inv, o1 * inv);
    LDS_WAIT(); asm volatile("" ::: "memory");
}

__device__ __forceinline__ void p_router(const Args& a, LAS float* ldsf, int bid, int G, int wave, int lane, int tid, float* GW, int* LIST, unsigned* cnt) {
    typedef short bf16x8 __attribute__((ext_vector_type(8)));
    const float* X1 = (const float*)(a.ws + WS_X1); const bf16_t* WRH = (const bf16_t*)(a.ws + WS_WRH); const bf16_t* WRL = (const bf16_t*)(a.ws + WS_WRL);
    float* RS1 = (float*)(a.ws + WS_RS1);
    LAS float* part = ldsf;
    LAS float* ssp = ldsf + 8 * 32 * 48;
    LAS float* lgt = ssp + 8 * 32;
    LAS int* asgE = (LAS int*)(lgt + 32 * 36); LAS float* asgW = (LAS float*)(asgE + 64); LAS int* lcnt = (LAS int*)(asgW + 64); LAS int* lbase = lcnt + 32;
    for (int tb = bid; tb < T / 32; tb += G) {
        const int m0 = tb * 32, fr = lane & 15, fq = lane >> 4;
        f32x4 acc[2][3];
#pragma unroll
        for (int mt = 0; mt < 2; ++mt)
#pragma unroll
            for (int nt = 0; nt < 3; ++nt) acc[mt][nt] = (f32x4){0.f, 0.f, 0.f, 0.f};
        float ss0 = 0.f, ss1 = 0.f;
#pragma unroll 2
        for (int ks = 0; ks < 8; ++ks) {
            const int kk = wave * 256 + ks * 32 + 8 * fq;
            bf16x8 ah[2], al[2], bh[3], bl[3];
#pragma unroll
            for (int mt = 0; mt < 2; ++mt) { const float* xp = X1 + (size_t)(m0 + 16 * mt + fr) * DM + kk; const f32x4 x0 = *(const f32x4*)xp, x1 = *(const f32x4*)(xp + 4);
                const float sq = (x0.x * x0.x + x0.y * x0.y) + (x0.z * x0.z + x0.w * x0.w) + (x1.x * x1.x + x1.y * x1.y) + (x1.z * x1.z + x1.w * x1.w);
                if (mt == 0) ss0 += sq; else ss1 += sq;
                u32x4 hw = pg8::pack8(x0, x1);
                const f32x4 r0 = {x0.x - bflo(hw.x), x0.y - bfhi(hw.x), x0.z - bflo(hw.y), x0.w - bfhi(hw.y)}, r1 = {x1.x - bflo(hw.z), x1.y - bfhi(hw.z), x1.z - bflo(hw.w), x1.w - bfhi(hw.w)};
                u32x4 lw = pg8::pack8(r0, r1);
                ah[mt] = *reinterpret_cast<bf16x8*>(&hw); al[mt] = *reinterpret_cast<bf16x8*>(&lw); }
#pragma unroll
            for (int nt = 0; nt < 3; ++nt) { bh[nt] = *(const bf16x8*)(WRH + (size_t)(16 * nt + fr) * DM + kk); bl[nt] = *(const bf16x8*)(WRL + (size_t)(16 * nt + fr) * DM + kk); }
#pragma unroll
            for (int mt = 0; mt < 2; ++mt)
#pragma unroll
                for (int nt = 0; nt < 3; ++nt) {
                    acc[mt][nt] = __builtin_amdgcn_mfma_f32_16x16x32_bf16(ah[mt], bh[nt], acc[mt][nt], 0, 0, 0);
                    acc[mt][nt] = __builtin_amdgcn_mfma_f32_16x16x32_bf16(ah[mt], bl[nt], acc[mt][nt], 0, 0, 0);
                    acc[mt][nt] = __builtin_amdgcn_mfma_f32_16x16x32_bf16(al[mt], bh[nt], acc[mt][nt], 0, 0, 0); }
        }
#pragma unroll
        for (int mt = 0; mt < 2; ++mt)
#pragma unroll
            for (int nt = 0; nt < 3; ++nt)
#pragma unroll
                for (int r = 0; r < 4; ++r) part[(wave * 32 + 16 * mt + 4 * fq + r) * 48 + 16 * nt + fr] = acc[mt][nt][r];
        ss0 += __shfl_xor(ss0, 16); ss0 += __shfl_xor(ss0, 32); ss1 += __shfl_xor(ss1, 16); ss1 += __shfl_xor(ss1, 32);
        if (fq == 0) { ssp[wave * 32 + fr] = ss0; ssp[wave * 32 + 16 + fr] = ss1; }
        if (tid < 32) lcnt[tid] = 0;
        __syncthreads();
        if (lane < 36) {
#pragma unroll
            for (int t = 0; t < 4; ++t) { const int row = wave * 4 + t; float v = 0.f, q = 0.f;
#pragma unroll
                for (int w = 0; w < 8; ++w) { v += part[(w * 32 + row) * 48 + lane]; q += ssp[w * 32 + row]; }
                const float rstd = 1.0f / sqrtf(q * (1.0f / DM) + EPS);
                lgt[row * 36 + lane] = v * rstd; if (lane == 0) RS1[m0 + row] = rstd; }
        }
        asm volatile("s_waitcnt lgkmcnt(0)" ::: "memory");
        if (lane < 4) {
            const int row = wave * 4 + lane; const LAS float* lg = lgt + row * 36;
            const f32x4 gl = *(const LAS f32x4*)(lg + 32);
            int gs = 0; float gm = gl[0];
#pragma unroll
            for (int i = 1; i < 4; ++i) if (gl[i] > gm) { gm = gl[i]; gs = i; }
            float den = 0.f;
#pragma unroll
            for (int i = 0; i < 4; ++i) den += expf(gl[i] - gm);
            const float pg = 1.f / den;
            const f32x4 e0 = *(const LAS f32x4*)(lg + gs * 8), e1 = *(const LAS f32x4*)(lg + gs * 8 + 4);
            float ev[8] = {e0.x, e0.y, e0.z, e0.w, e1.x, e1.y, e1.z, e1.w};
            int i0 = 0; float v0 = ev[0];
#pragma unroll
            for (int i = 1; i < 8; ++i) if (ev[i] > v0) { v0 = ev[i]; i0 = i; }
            int i1 = -1; float v1 = -3.0e38f;
#pragma unroll
            for (int i = 0; i < 8; ++i) if (i != i0 && ev[i] > v1) { v1 = ev[i]; i1 = i; }
            const float ee = expf(v1 - v0); const float w0 = 1.f / (1.f + ee), w1 = ee / (1.f + ee);
            const int la = 2 * row;
            asgE[la] = gs * 8 + i0; asgE[la + 1] = gs * 8 + i1; asgW[la] = w0 * pg; asgW[la + 1] = w1 * pg;
        }
        __syncthreads();
        if (wave == 0) {
            const int e = asgE[lane];
            const int rank = (int)__hip_atomic_fetch_add((LAS unsigned*)&lcnt[e], 1u, __ATOMIC_RELAXED, __HIP_MEMORY_SCOPE_WORKGROUP);
            asm volatile("s_waitcnt lgkmcnt(0)" ::: "memory");
            if (lane < 32) { const int c = lcnt[lane]; lbase[lane] = c > 0 ? (int)atomicAdd(&cnt[lane], (unsigned)c) : 0; }
            asm volatile("s_waitcnt vmcnt(0) lgkmcnt(0)" ::: "memory");
            const int pos = lbase[e] + rank; const int asg = 2 * (tb * 32) + lane;
            LIST[(size_t)e * T + pos] = asg; GW[asg] = asgW[lane];
        }
        __syncthreads();
    }
}

#define XB_TMO      128
#define XB_XCNT(j)  (256  + 64 * (j))
#define XB_XSUB(j)  (1280 + 64 * (j))
#define XB_XGEN(j)  (2304 + 64 * (j))
#define XB_TOP      3328
#define XB_TOPGEN   3392
#define XCD_BAR_WORDS 3456
#define XB_SPIN_CAP (1u << 22)
__device__ __forceinline__ unsigned xb_ld(unsigned* p)              { return __hip_atomic_load(p, __ATOMIC_RELAXED, __HIP_MEMORY_SCOPE_AGENT); }
__device__ __forceinline__ unsigned xb_add(unsigned* p, unsigned v) { return __hip_atomic_fetch_add(p, v, __ATOMIC_RELAXED, __HIP_MEMORY_SCOPE_AGENT); }
__device__ __forceinline__ unsigned xb_xcc_id() { return (unsigned)__builtin_amdgcn_s_getreg((3 << 11) | 20) & 0xFu; }
#define XB_SPIN(cond, bar) do { unsigned _sp = 0; while (cond) { __builtin_amdgcn_s_sleep(1); \
    if ((++_sp & 255u) == 0u) { if (xb_ld(&(bar)[XB_TMO])) break; if (_sp > XB_SPIN_CAP) { atomicAdd(&(bar)[XB_TMO], 1u); break; } } } } while (0)
struct XcdBarrier { unsigned* bar; unsigned x; volatile LAS unsigned* st; };
__device__ __forceinline__ XcdBarrier xcd_barrier_post(unsigned* bar, volatile LAS unsigned* st) {
    XcdBarrier b; b.bar = bar; b.x = xb_xcc_id(); b.st = st;
    if (threadIdx.x == 0) (void)xb_add(&bar[XB_XCNT(b.x)], 1u);
    return b;
}
__device__ __forceinline__ void xcd_barrier_complete(unsigned* bar, unsigned x, unsigned& nloc, unsigned& nx) {
    const unsigned G = gridDim.x * gridDim.y * gridDim.z;
    unsigned sum, cnt, mine, sp = 0u;
    for (;;) {
        sum = 0u; cnt = 0u; mine = 0u;
#pragma unroll
        for (unsigned j = 0; j < 16; ++j) { const unsigned c = xb_ld(&bar[XB_XCNT(j)]); sum += c; cnt += (c > 0u) ? 1u : 0u; mine = (j == x) ? c : mine; }
        if (sum == G) break;
        __builtin_amdgcn_s_sleep(1);
        if ((++sp & 255u) == 0u) { if (xb_ld(&bar[XB_TMO])) break; if (sp > XB_SPIN_CAP) { atomicAdd(&bar[XB_TMO], 1u); break; } }
    }
    nloc = mine > 0u ? mine : 1u; nx = cnt > 0u ? cnt : 1u;
}
__device__ __forceinline__ void xcd_barrier(unsigned* bar, volatile LAS unsigned* st) {
    asm volatile("s_waitcnt vmcnt(0)" ::: "memory");
    __syncthreads();
    if (threadIdx.x == 0) {
        __builtin_amdgcn_s_waitcnt(0);
        const unsigned x = xb_xcc_id();
        unsigned nloc = st[0], nx = st[1];
        if (nloc == 0u) { xcd_barrier_complete(bar, x, nloc, nx); st[0] = nloc; st[1] = nx; }
        const unsigned old = xb_add(&bar[XB_XSUB(x)], 1u);
        const unsigned gen = old / nloc;
        if (old + 1u == (gen + 1u) * nloc) {
            __builtin_amdgcn_fence(__ATOMIC_RELEASE, "agent");
            asm volatile("s_waitcnt vmcnt(0)" ::: "memory");
            const unsigned og = xb_add(&bar[XB_TOP], 1u);
            const unsigned tg = og / nx;
            if (og + 1u == (tg + 1u) * nx) xb_add(&bar[XB_TOPGEN], 1u);
            else XB_SPIN(xb_ld(&bar[XB_TOPGEN]) == tg, bar);
            __builtin_amdgcn_fence(__ATOMIC_ACQUIRE, "agent");
            xb_add(&bar[XB_XGEN(x)], 1u);
            asm volatile("s_waitcnt vmcnt(0)" ::: "memory");
        } else {
            XB_SPIN(xb_ld(&bar[XB_XGEN(x)]) == gen, bar);
            __builtin_amdgcn_fence(__ATOMIC_ACQUIRE, "agent");
            asm volatile("s_waitcnt vmcnt(0)" ::: "memory");
        }
    }
    __syncthreads();
}

#define GRID_SYNC() do { xcd_barrier(xbar, xst); asm volatile("" ::: "memory"); } while (0)
constexpr int CW_BAR = 4096;
constexpr int XST_OFF = LDS_BYTES - 64;
__global__ void __launch_bounds__(NTHREADS, 2) fwd_megakernel(Args a) {
    extern __shared__ __attribute__((aligned(16))) unsigned char lds_raw[];
    volatile LAS unsigned* xst = (volatile LAS unsigned*)((LAS unsigned char*)lds_raw + XST_OFF);
    unsigned* xbar = (unsigned*)(a.ws + WS_CTL) + CW_BAR;
    if (threadIdx.x < 16) xst[threadIdx.x] = 0u;
    __syncthreads();
    (void)xcd_barrier_post(xbar, xst);
    LAS unsigned char* lds = (LAS unsigned char*)lds_raw;
    LAS float* ldsf = (LAS float*)lds_raw;
#define FRESH_IDS() int tid = threadIdx.x; asm volatile("" : "+v"(tid)); const int lane = tid & 63, wave = __builtin_amdgcn_readfirstlane(tid >> 6); \
    int G = gridDim.x, bid = blockIdx.x; asm volatile("" : "+s"(G), "+s"(bid)); const int gw = bid * NWAVES + wave, NGW = G * NWAVES; \
    unsigned char* ws = a.ws; (void)lane; (void)gw; (void)NGW; (void)ws; (void)wave;

    { FRESH_IDS(); p0_prologue(a, lds, gw, NGW, wave, lane, tid); }
    GRID_SYNC();
    { FRESH_IDS(); p_cumsum(a, ldsf, bid, wave, lane, tid); }
    if (FAST(1)) { FRESH_IDS();
        pg8::Gemm g{{(const bf16_t*)(ws + WS_H), nullptr}, {(const bf16_t*)(ws + WS_WTIN), nullptr}, DM};
        pg8::DenseOrder<1> S; S.init(T, NPROJ, G, bid);
        EpiP1 E{(bf16_t*)(ws + WS_QKV), (bf16_t*)(ws + WS_GATES), (float*)(ws + WS_NSQ)};
        pg8::gemm_phase<EpiP1, pg8::DenseOrder<1>, false>(lds, g, S, E);
    }
    if (FAST(9) && !FAST(2)) { FRESH_IDS();
        pg8::Gemm g2{{(const bf16_t*)(ws + WS_PB), nullptr}, {(const bf16_t*)(ws + WS_WTPP), nullptr}, DPLE};
        pg8::DenseOrder<1> S2; S2.init(T, DM, G, bid);
        EpiStoreBf E2{(bf16_t*)(ws + WS_PLE), DM};
        pg8::gemm_phase<EpiStoreBf, pg8::DenseOrder<1>, false>(lds, g2, S2, E2);
    }
    if (!FAST(1)) { FRESH_IDS();
        const bf16_t* H = (const bf16_t*)(ws + WS_H); const bf16_t* WTIN = (const bf16_t*)(ws + WS_WTIN);
        bf16_t* QKV = (bf16_t*)(ws + WS_QKV); bf16_t* GATES = (bf16_t*)(ws + WS_GATES);
        auto epi = [&](int m, int n, f32x4 c, f32x4) {
            if (n < NQKV) st_bf4(QKV + (size_t)m * NQKV + n, c);
            else { f32x4 s = {sigmoidf(c.x), sigmoidf(c.y), sigmoidf(c.z), sigmoidf(c.w)}; st_bf4(GATES + (size_t)m * 4096 + (n - NQKV), s); }
        };
        constexpr int NMT = T / GBM, NNT = NPROJ / GBN;
        for (int u = bid; u < NMT * NNT; u += G) { const int mt = u / NNT, nt = u % NNT;
            base_gemm_tile<1>(H, H, DM, nullptr, 0, T, WTIN, WTIN, DM, DM, mt * GBM, nt * GBN, ldsf, epi); }
    }
    if (!FAST(9)) { FRESH_IDS();
        constexpr int NMT = T / GBM;
        const bf16_t* PB = (const bf16_t*)(ws + WS_PB); const bf16_t* WTPP = (const bf16_t*)(ws + WS_WTPP); bf16_t* PLE = (bf16_t*)(ws + WS_PLE);
        auto epi2 = [&](int m, int n, f32x4 c, f32x4) { st_bf4(PLE + (size_t)m * DM + n, c); };
        constexpr int NNT2 = DM / GBN;
        for (int u = bid; u < NMT * NNT2; u += G) { const int mt = u / NNT2, nt = u % NNT2;
            base_gemm_tile<1>(PB, PB, DPLE, nullptr, 0, T, WTPP, WTPP, DPLE, DPLE, mt * GBM, nt * GBN, ldsf, epi2); }
    }
    GRID_SYNC();
    if (FAST(2)) { FRESH_IDS();
        constexpr int N_FOX = 24 * 16, N_SB = 16 * 16, N_PLE = 256, N_COMP = N_FOX + N_SB + N_PLE, N_CONV = N_CONV_CHUNKS;
        const bool conv_first = ((bid >> 3) % 3) == 0;
        LAS unsigned* qslot = (LAS unsigned*)(lds + 140 * 1024);
        int mode = conv_first ? 1 : 0, switches = 0;
        for (;;) {
            if (threadIdx.x == 0) qslot[0] = __hip_atomic_fetch_add((unsigned*)(ws + WS_CTL) + CW_QHEAD + (mode ? 32 : 0), 1u, __ATOMIC_RELAXED, __HIP_MEMORY_SCOPE_AGENT);
            __syncthreads();
            const int pos = (int)qslot[0];
            __syncthreads();
            const bool valid = pos < (mode ? N_CONV : N_COMP);
            if (!valid) { mode ^= 1; if (++switches >= 2) break; }
            const int conv = (valid && mode) ? pos : -1, comp = (valid && !mode) ? pos : -1;
            if (!valid) {}
            else
            if (conv >= 0) {
                int t2 = threadIdx.x; asm volatile("" : "+v"(t2)); const int lane2 = t2 & 63, wave2 = __builtin_amdgcn_readfirstlane(t2 >> 6);
                LAS float* scr = (LAS float*)(lds + wave2 * 8704);
                conv_wave(a, conv * CONV_CHUNK + wave2, NWAVES, CONV_CHUNK / NWAVES, scr, lane2);
                __syncthreads();
            } else if (comp < N_FOX) {
                const int bh = comp & 15, e = comp >> 4;
                int qb, part;
                {
                  const int pair = e / 5, w = e % 5;
                  if (e < 20) { if (w < 3) { qb = w < 2 ? 15 - 2 * pair : 7 - pair; part = w < 2 ? w : -1; } else { qb = 14 - 2 * pair; part = w - 3; } }
                  else { qb = 23 - e; part = -1; } }
                const int b = bh >> 3, h = bh & 7, P0 = qb * 256, NTF = P0 / 64 + 4;
                const bf16_t* Qp = (const bf16_t*)(ws + WS_QKV) + (size_t)(b * SEQ) * NQKV + h * HD;
                const float* NBp = (const float*)(ws + WS_NB) + (size_t)(b * NH + h) * SEQ;
                const size_t orow = (size_t)(b * SEQ + P0);
                bf16_t* Op = (bf16_t*)(ws + (part == 0 ? WS_OA2 : WS_OA)) + orow * WA + h * HD;
                float* lse = part < 0 ? nullptr : (float*)(ws + (part == 0 ? WS_LSE2 : WS_LSE1)) + orow * 8 + h;
                int t0 = part == 1 ? NTF / 2 : 0; const int t1 = part == 0 ? NTF / 2 : NTF;
                {
                  int t5 = threadIdx.x; asm volatile("" : "+v"(t5));
                  const float* NK = (const float*)(ws + WS_NSQ) + (size_t)((8 + h) * 4) * T + (size_t)b * SEQ; const float* NQ = (const float*)(ws + WS_NSQ) + (size_t)(h * 4) * T + (size_t)b * SEQ;
                  float kq = 0.f, qq = 0.f;
#pragma unroll 1
                  for (int i = t5; i < P0 + 256; i += NTHREADS) kq = fmaxf(kq, (NK[i] + NK[T + i]) + (NK[2 * T + i] + NK[3 * T + i]));
                  if (t5 < 256) { const int i = P0 + t5; qq = (NQ[i] + NQ[T + i]) + (NQ[2 * T + i] + NQ[3 * T + i]); }
                  kq = fmaxf(kq, att::xor1(kq)); kq = fmaxf(kq, att::xor2(kq)); kq = fmaxf(kq, att::xorsw<4>(kq)); kq = fmaxf(kq, att::xorsw<8>(kq)); kq = fmaxf(kq, att::xorsw<16>(kq)); kq = att::half_swap_max(kq);
                  qq = fmaxf(qq, att::xor1(qq)); qq = fmaxf(qq, att::xor2(qq)); qq = fmaxf(qq, att::xorsw<4>(qq)); qq = fmaxf(qq, att::xorsw<8>(qq)); qq = fmaxf(qq, att::xorsw<16>(qq)); qq = att::half_swap_max(qq);
                  LAS float* red = (LAS float*)(lds + 141 * 1024);
                  if ((t5 & 63) == 0) { red[t5 >> 6] = kq; red[8 + (t5 >> 6)] = qq; }
                  __syncthreads();
                  float k2 = red[0], q2 = red[8];
#pragma unroll
                  for (int i = 1; i < 8; ++i) { k2 = fmaxf(k2, red[i]); q2 = fmaxf(q2, red[8 + i]); }
                  const float thr = NBp[P0] - 2.02f * __builtin_sqrtf(k2 * q2) - 1250.f;
                  const int j = t5 & 63; const bool keep = j < NTF && NBp[64 * j + 63] >= thr;
                  const unsigned long long bal = __ballot(keep);
                  const int tf = bal ? (int)__builtin_ctzll(bal) : 0;
                  t0 = max(t0, min(tf, t1 - 1));
                  __syncthreads(); }
                att::attn_unit<0>(Qp + (size_t)P0 * NQKV, Qp + 1024, Qp + 2048, Op, NBp, P0, t0, t1, lse, (LAS char*)lds);
            } else if (comp >= N_FOX + N_SB) {
                const int v = comp - N_FOX - N_SB;
                pg8::Gemm g2{{(const bf16_t*)(ws + WS_PB), nullptr}, {(const bf16_t*)(ws + WS_WTPP), nullptr}, DPLE};
                OneUnit S2{v >> 3, v & 7}; EpiStoreBf E2{(bf16_t*)(ws + WS_PLE), DM};
                pg8::gemm_phase<EpiStoreBf, OneUnit, false>(lds, g2, S2, E2);
            } else {
                const int u = comp - N_FOX, bh = u & 15, qb = 15 - (u >> 4);
                const int b = bh >> 3, h = bh & 7, P0 = qb * 256;
                const bf16_t* Qp = (const bf16_t*)(ws + WS_QKV) + (size_t)(b * SEQ) * NQKV + 3072 + h * HD;
                bf16_t* Op = (bf16_t*)(ws + WS_OB) + (size_t)(b * SEQ + P0) * WA + h * HD;
                att::attn_unit<1>(Qp + (size_t)P0 * NQKV, Qp + 1024, Qp + 2048, Op, nullptr, P0, 0, P0 / 64 + 4, nullptr, (LAS char*)lds);
            }
        }
        GRID_SYNC();
    }
    if (FAST(2)) { FRESH_IDS();
        { const bf16_t* O2 = (const bf16_t*)(ws + WS_OA2); bf16_t* O1 = (bf16_t*)(ws + WS_OA); const float* L1 = (const float*)(ws + WS_LSE1); const float* L2 = (const float*)(ws + WS_LSE2);
          for (int task = gw; task < NBATCH * 2048 * NH; task += NGW) { const int h = task & 7, rr = task >> 3; const int b = rr >> 11, sq = 2048 + (rr & 2047); const size_t row = (size_t)b * SEQ + sq;
              const float l1 = L1[row * 8 + h], l2 = L2[row * 8 + h], mx = fmaxf(l1, l2); const float e1 = __builtin_amdgcn_exp2f(l1 - mx), e2 = __builtin_amdgcn_exp2f(l2 - mx), inv = 1.f / (e1 + e2);
              const unsigned w1 = *(const unsigned*)(O1 + row * WA + h * HD + 2 * lane), w2 = *(const unsigned*)(O2 + row * WA + h * HD + 2 * lane);
              *(unsigned*)(O1 + row * WA + h * HD + 2 * lane) = pk2((bflo(w1) * e1 + bflo(w2) * e2) * inv, (bfhi(w1) * e1 + bfhi(w2) * e2) * inv); } }
    }
    if (!FAST(2) && PH(2)) { FRESH_IDS();
        LAS float* S = ldsf + wave * 4096; LAS float* qs = ldsf + 8 * 4096 + wave * 128;
        const int ntask = 2 * NBATCH * NH * SEQ;
        for (int task = gw; task < ntask; task += NGW) {
            const int c = task & 31, t = task >> 5; const int br = c >> 4, b = (c >> 3) & 1, h = c & 7;
            base_attn_row(a, br, b, h, t, S, qs, lane);
        }
    }
    GRID_SYNC();
    if (FAST(3)) { FRESH_IDS();
        pg8::Gemm g{{(const bf16_t*)(ws + WS_OA), (const bf16_t*)(ws + WS_OB)}, {(const bf16_t*)(ws + WS_WTBF), (const bf16_t*)(ws + WS_WTBS)}, WA};
        pg8::DenseOrder<2> S; S.init(T, DM, G, bid);
        EpiP3 E{(const bf16_t*)(ws + WS_GATES), (bf16_t*)(ws + WS_MIXED)};
        pg8::gemm_phase<EpiP3, pg8::DenseOrder<2>, false>(lds, g, S, E);
    }
    else { FRESH_IDS();
        const bf16_t* OA = (const bf16_t*)(ws + WS_OA); const bf16_t* OB = (const bf16_t*)(ws + WS_OB);
        const bf16_t* WTBF = (const bf16_t*)(ws + WS_WTBF); const bf16_t* WTBS = (const bf16_t*)(ws + WS_WTBS);
        const bf16_t* GATES = (const bf16_t*)(ws + WS_GATES); bf16_t* MIXED = (bf16_t*)(ws + WS_MIXED);
        auto epi = [&](int m, int n, f32x4 ca, f32x4 cb) {
            const f32x4 ga = ld_bf4(GATES + (size_t)m * 4096 + n), gb = ld_bf4(GATES + (size_t)m * 4096 + 2048 + n);
            st_bf4(MIXED + (size_t)m * DM + n, ga * ca + gb * cb);
        };
        constexpr int NMT = T / GBM, NNT = DM / GBN;
        for (int u = bid; u < NMT * NNT; u += G) { const int mt = u / NNT, nt = u % NNT;
            base_gemm_tile<2>(OA, OB, WA, nullptr, 0, T, WTBF, WTBS, WA, WA, mt * GBM, nt * GBN, ldsf, epi); }
    }
    GRID_SYNC();
    if (FAST(4)) { FRESH_IDS();
        pg8::Gemm g{{(const bf16_t*)(ws + WS_MIXED), nullptr}, {(const bf16_t*)(ws + WS_WTMIX), nullptr}, DM};
        pg8::DenseOrder<1> S; S.init(T, DM, G, bid);
        EpiP4 E{a.in[0], (float*)(ws + WS_X1), (bf16_t*)(ws + WS_X1B)};
        pg8::gemm_phase<EpiP4, pg8::DenseOrder<1>, false>(lds, g, S, E);
    }
    else { FRESH_IDS();
        const bf16_t* MIXED = (const bf16_t*)(ws + WS_MIXED); const bf16_t* WTMIX = (const bf16_t*)(ws + WS_WTMIX);
        const float* x = a.in[0]; float* X1 = (float*)(ws + WS_X1); bf16_t* X1B = (bf16_t*)(ws + WS_X1B);
        auto epi = [&](int m, int n, f32x4 c, f32x4) {
            const f32x4 r = *(const f32x4*)(x + (size_t)m * DM + n) + c;
            *(f32x4*)(X1 + (size_t)m * DM + n) = r; st_bf4(X1B + (size_t)m * DM + n, r);
        };
        constexpr int NMT = T / GBM, NNT = DM / GBN;
        for (int u = bid; u < NMT * NNT; u += G) { const int mt = u / NNT, nt = u % NNT;
            base_gemm_tile<1>(MIXED, MIXED, DM, nullptr, 0, T, WTMIX, WTMIX, DM, DM, mt * GBM, nt * GBN, ldsf, epi); }
    }
    GRID_SYNC();
    { FRESH_IDS(); p_router(a, ldsf, bid, G, wave, lane, tid, (float*)(ws + WS_GW), (int*)(ws + WS_LIST), (unsigned*)(ws + WS_CTL) + CW_CNT); }
    GRID_SYNC();
    if (FAST(6)) { FRESH_IDS();
        const unsigned* cnt = (const unsigned*)(ws + WS_CTL) + CW_CNT;
        LAS int* tab = (LAS int*)(lds + MOE_TAB_OFF); LAS int* toks = (LAS int*)(lds + MOE_TOK_OFF);
        const int* LIST = (const int*)(ws + WS_LIST);
        if (tid == 0) { int mp = 0; for (int e = 0; e < NEXP; ++e) { const int c = (int)__hip_atomic_load(cnt + e, __ATOMIC_RELAXED, __HIP_MEMORY_SCOPE_AGENT);
                tab[e] = mp; tab[64 + e] = c; mp += (c + 255) / 256; } tab[NEXP] = mp; }
        __syncthreads();
        const int nmt = tab[NEXP];
        const int m1 = nmt < 64 ? nmt : 64, n2 = (nmt - m1) * 4;
        pg8::Gemm gGU{{(const bf16_t*)(ws + WS_X1B), nullptr}, {(const bf16_t*)(ws + WS_WTGU), nullptr}, DM};
        pg8::Gemm gDN{{(const bf16_t*)(ws + WS_HID), nullptr}, {(const bf16_t*)(ws + WS_WTDN), nullptr}, DEXP};
        EpiGU EGU{(bf16_t*)(ws + WS_HID), (const float*)(ws + WS_RS1), toks};
        EpiDN EDN{(bf16_t*)(ws + WS_YB), (const float*)(ws + WS_GW), LIST, tab};
#define MOE_FILL_TOKS(S) do { for (int i = 0; i < MOE_MAXU; ++i) { const int L = (S).unit(i); if (L < 0) break; int e, mt, nt_; (S).decode(L, e, mt, nt_); \
            if (tid < 256) { int r = mt * 256 + tid; const int c = tab[64 + e]; if (r > c - 1) r = c - 1; toks[i * 256 + tid] = LIST[(size_t)e * T + r] >> 1; } } __syncthreads(); } while (0)
        {
            MoeOrder<4> S{tab, toks, 0, m1 * 4, G, bid};
            MOE_FILL_TOKS(S);
            pg8::gemm_phase<EpiGU, MoeOrder<4>, true>(lds, gGU, S, EGU);
        }
        GRID_SYNC();
        {
            if (bid < n2) { MoeOrder<4> S{tab, toks, m1 * 4, nmt * 4, G, bid}; MOE_FILL_TOKS(S); pg8::gemm_phase<EpiGU, MoeOrder<4>, true>(lds, gGU, S, EGU); }
            else { MoeOrder<8> S{tab, toks, 0, m1 * 8, G - n2, bid - n2}; pg8::gemm_phase<EpiDN, MoeOrder<8>, false>(lds, gDN, S, EDN); }
        }
        GRID_SYNC();
        {
            MoeOrder<8> S{tab, toks, m1 * 8, nmt * 8, G, bid};
            pg8::gemm_phase<EpiDN, MoeOrder<8>, false>(lds, gDN, S, EDN);
        }
#undef MOE_FILL_TOKS
    }
    else { FRESH_IDS();
        const unsigned* cnt = (const unsigned*)(ws + WS_CTL) + CW_CNT;
        LAS int* tab = (LAS int*)(lds + 140 * 1024);
        if (tid == 0) { int mp = 0, off = 0; for (int e = 0; e < NEXP; ++e) { const int c = (int)__hip_atomic_load(cnt + e, __ATOMIC_RELAXED, __HIP_MEMORY_SCOPE_AGENT);
                tab[e] = mp; tab[64 + e] = off; mp += (c + GBM - 1) / GBM; off += ((c + 255) / 256) * 256; } tab[NEXP] = mp; tab[64 + NEXP] = off; }
        __syncthreads();
        const int nmt = tab[NEXP];
        const bf16_t* X1B = (const bf16_t*)(ws + WS_X1B); const bf16_t* WTGU = (const bf16_t*)(ws + WS_WTGU); const bf16_t* WTDN = (const bf16_t*)(ws + WS_WTDN);
        bf16_t* HID = (bf16_t*)(ws + WS_HID); bf16_t* YB = (bf16_t*)(ws + WS_YB);
        const int* LIST = (const int*)(ws + WS_LIST); const float* RS1 = (const float*)(ws + WS_RS1); const float* GW = (const float*)(ws + WS_GW);
        constexpr int NNT_H = DEXP / GBN;
        for (int u = bid; u < nmt * NNT_H; u += G) {
            const int mtg = u / NNT_H, nt = u % NNT_H;
            int e = 0;
            for (int q = 1; q < NEXP; ++q) if (tab[q] <= mtg) e = q;
            const int mt = mtg - tab[e], c = (int)cnt[e], off = tab[64 + e];
            const int* rl = LIST + (size_t)e * T;
            const int hc0 = nt * GBN, tt = hc0 >> 7, w = hc0 & 127;
            const bf16_t* Bg = WTGU + ((size_t)e * 1024 + tt * 256 + w) * DM; const bf16_t* Bu = Bg + (size_t)128 * DM;
            auto epi = [&](int m, int n, f32x4 cg_, f32x4 cu_) {
                const float rs = RS1[rl[m] >> 1];
                f32x4 hv;
#pragma unroll
                for (int i = 0; i < 4; ++i) { const float g = cg_[i] * rs, uu = cu_[i] * rs; hv[i] = g * sigmoidf(g) * uu; }
                st_bf4(HID + (size_t)(off + m) * DEXP + hc0 + n, hv);
            };
            base_gemm_tile<2>(X1B, X1B, DM, rl, 1, c, Bg, Bu, DM, DM, mt * GBM, 0, ldsf, epi);
        }
        GRID_SYNC();
        constexpr int NNT_D = DM / GBN;
        for (int u = bid; u < nmt * NNT_D; u += G) {
            const int mtg = u / NNT_D, nt = u % NNT_D;
            int e = 0;
            for (int q = 1; q < NEXP; ++q) if (tab[q] <= mtg) e = q;
            const int mt = mtg - tab[e], c = (int)cnt[e], off = tab[64 + e];
            const int* rl = LIST + (size_t)e * T;
            const bf16_t* Ah = HID + (size_t)off * DEXP; const bf16_t* Bd = WTDN + (size_t)e * DM * DEXP;
            auto epi = [&](int m, int n, f32x4 cacc, f32x4) { const int as = rl[m]; st_bf4(YB + (size_t)as * DM + n, cacc * GW[as]); };
            base_gemm_tile<1>(Ah, Ah, DEXP, nullptr, 0, c, Bd, Bd, DEXP, DEXP, mt * GBM, nt * GBN, ldsf, epi);
        }
    }
    GRID_SYNC();
    { FRESH_IDS();
        bf16_t* X2B = (bf16_t*)(ws + WS_X1B); const bf16_t* YB = (const bf16_t*)(ws + WS_YB); float* RS2 = (float*)(ws + WS_RS2);
        for (int m = gw; m < T; m += NGW) {
            const u32x2* y0 = (const u32x2*)(YB + (size_t)(2 * m) * DM) + lane; const u32x2* y1 = (const u32x2*)(YB + (size_t)(2 * m + 1) * DM) + lane;
            u32x2* xb = (u32x2*)(X2B + (size_t)m * DM) + lane;
            float ss = 0.f;
#pragma unroll
            for (int j = 0; j < 8; ++j) {
                const u32x2 xv = xb[64 * j], a0 = y0[64 * j], a1 = y1[64 * j];
                f32x4 v = {bflo(xv.x), bfhi(xv.x), bflo(xv.y), bfhi(xv.y)};
                v.x += bflo(a0.x) + bflo(a1.x); v.y += bfhi(a0.x) + bfhi(a1.x); v.z += bflo(a0.y) + bflo(a1.y); v.w += bfhi(a0.y) + bfhi(a1.y);
                u32x2 o; o.x = pk2(v.x, v.y); o.y = pk2(v.z, v.w); xb[64 * j] = o;
                v = (f32x4){bflo(o.x), bfhi(o.x), bflo(o.y), bfhi(o.y)};
                ss += (v.x * v.x + v.y * v.y) + (v.z * v.z + v.w * v.w);
            }
            ss = wave_sum(ss);
            if (lane == 0) RS2[m] = 1.0f / sqrtf(ss * (1.0f / DM) + EPS);
        }
    }
    GRID_SYNC();
    if (FAST(8)) { FRESH_IDS();
        pg8::Gemm g{{(const bf16_t*)(ws + WS_X1B), nullptr}, {(const bf16_t*)(ws + WS_WTPG), nullptr}, DM};
        pg8::DenseOrder<1> S; S.init(T, DM, G, bid);
        if (G == 256) { EpiP8Fused E{(const bf16_t*)(ws + WS_X1B), (const float*)(ws + WS_RS2), (const bf16_t*)(ws + WS_PLE), a.out, a.in[17], (float*)(ws + WS_SS),
                                     (unsigned*)(ws + WS_CTL) + CW_PANEL, (unsigned*)(ws + WS_CTL) + 2};
            pg8::gemm_phase<EpiP8Fused, pg8::DenseOrder<1>, false>(lds, g, S, E); }
        else { EpiP8 E{(const bf16_t*)(ws + WS_X1B), (const float*)(ws + WS_RS2), (const bf16_t*)(ws + WS_PLE), a.out};
            pg8::gemm_phase<EpiP8, pg8::DenseOrder<1>, false>(lds, g, S, E); }
    }
    else { FRESH_IDS();
        const bf16_t* X2B = (const bf16_t*)(ws + WS_X1B); const bf16_t* WTPG = (const bf16_t*)(ws + WS_WTPG); const bf16_t* PLE = (const bf16_t*)(ws + WS_PLE);
        const float* RS2 = (const float*)(ws + WS_RS2); float* out = a.out;
        auto epi = [&](int m, int n, f32x4 c, f32x4) {
            const float rs = RS2[m]; const f32x4 pl = ld_bf4(PLE + (size_t)m * DM + n); const f32x4 xv = ld_bf4(X2B + (size_t)m * DM + n);
            f32x4 o;
#pragma unroll
            for (int i = 0; i < 4; ++i) o[i] = xv[i] + sigmoidf(c[i] * rs) * pl[i];
            *(f32x4*)(out + (size_t)m * DM + n) = o;
        };
        constexpr int NMT = T / GBM, NNT = DM / GBN;
        for (int u = bid; u < NMT * NNT; u += G) { const int mt = u / NNT, nt = u % NNT;
            base_gemm_tile<1>(X2B, X2B, DM, nullptr, 0, T, WTPG, WTPG, DM, DM, mt * GBM, nt * GBN, ldsf, epi); }
    }
    if (!(FAST(8) && gridDim.x == 256)) {
    GRID_SYNC();
    { FRESH_IDS();
        float* out = a.out; const float* g_final = a.in[17];
        for (int m = gw; m < T; m += NGW) {
            f32x4* xr = (f32x4*)(out + (size_t)m * DM) + lane; const f32x4* gr = (const f32x4*)g_final + lane;
            f32x4 v[8]; float ss = 0.f;
#pragma unroll
            for (int j = 0; j < 8; ++j) { v[j] = xr[64 * j]; ss += (v[j].x * v[j].x + v[j].y * v[j].y) + (v[j].z * v[j].z + v[j].w * v[j].w); }
            ss = wave_sum(ss);
            const float rstd = 1.0f / sqrtf(ss * (1.0f / DM) + EPS);
#pragma unroll
            for (int j = 0; j < 8; ++j) xr[64 * j] = v[j] * rstd * gr[64 * j];
        }
    }
    }
}

extern "C" void kernel_launch(void* const* d_in, const int* in_sizes, int n_in, void* d_out, int out_size, void* d_ws, size_t ws_size, hipStream_t stream) {
    static int grid_blocks = 0;
    if (grid_blocks == 0) {
        if (n_in != 18 || out_size != T * DM || ws_size < WS_END) {
            fprintf(stderr, "kernel_launch: unexpected problem (n_in %d, out %d, ws %zu < %zu)\n", n_in, out_size, ws_size, (size_t)WS_END); grid_blocks = -1; return; }
        int dev = 0, cus = 0, per_cu = 0;
        (void)hipGetDevice(&dev);
        (void)hipDeviceGetAttribute(&cus, hipDeviceAttributeMultiprocessorCount, dev);
        (void)hipFuncSetAttribute((const void*)fwd_megakernel, hipFuncAttributeMaxDynamicSharedMemorySize, LDS_BYTES);
        (void)hipOccupancyMaxActiveBlocksPerMultiprocessor(&per_cu, (const void*)fwd_megakernel, NTHREADS, LDS_BYTES);
        if (per_cu < 1) { fprintf(stderr, "kernel_launch: occupancy query says %d blocks per CU\n", per_cu); per_cu = 1; }
        grid_blocks = cus * per_cu;
        fprintf(stderr, "kernel_launch: %d CUs x %d = %d workgroups, ws %zu bytes (need %zu)\n", cus, per_cu, grid_blocks, ws_size, (size_t)WS_END);
    }
    if (grid_blocks < 0) return;
    (void)hipMemsetAsync((char*)d_ws + WS_CTL, 0, CTL_BYTES, stream);
    Args a{};
    for (int i = 0; i < 18; ++i) a.in[i] = (const float*)d_in[i];
    a.out = (float*)d_out; a.ws = (unsigned char*)d_ws;
    void* args[] = {&a};
    hipError_t e = hipLaunchCooperativeKernel((const void*)fwd_megakernel, dim3(grid_blocks), dim3(NTHREADS), args, LDS_BYTES, stream);
    if (e != hipSuccess) fprintf(stderr, "cooperative launch failed: %s (grid %d)\n", hipGetErrorString(e), grid_blocks);
}
```
